# Optimizing an MI355X kernel written in HIP

```python
import math
import jax, jax.numpy as jnp
from jax import lax
import numpy as np

D_MODEL = 4096
BATCH = 4
SEQ = 4096
DEPTH = 1

HEAD_DIM = 128
SB_HEADS = 16
SB_WIDTH = SB_HEADS * HEAD_DIM
DA_HEADS = 8
DA_WIDTH = DA_HEADS * 2 * HEAD_DIM
GATE_WIDTH = 2 * D_MODEL
IN_WIDTH = 3 * SB_WIDTH + 3 * DA_WIDTH + GATE_WIDTH
Q_BLOCK = 128
ROPE_THETA = 10000.0
PEER_HEADS = 8
PEER_N_KEYS = 128
PEER_EXPERTS = PEER_N_KEYS * PEER_N_KEYS
PEER_TOPK = 16
PEER_KEY_DIM = 256
PEER_HALF = PEER_KEY_DIM // 2
PEER_CHUNK = 128
LN_EPS = 1e-5
DEEPNORM_ALPHA = (2 * DEPTH) ** 0.25
DEEPNORM_BETA = (8 * DEPTH) ** -0.25

kernel_name = "hybrid_sb_diffattn_peer_deepnorm"


def layer_norm(x, g, b):
    xf = x.astype(jnp.float32)
    mu = jnp.mean(xf, axis=-1, keepdims=True)
    var = jnp.mean(jnp.square(xf - mu), axis=-1, keepdims=True)
    return ((xf - mu) * lax.rsqrt(var + LN_EPS) * g + b).astype(x.dtype)


def rms_norm(x, g):
    xf = x.astype(jnp.float32)
    return (xf * lax.rsqrt(jnp.mean(jnp.square(xf), axis=-1, keepdims=True) + LN_EPS) * g).astype(x.dtype)


def rope_tables(positions):
    inv_freq = ROPE_THETA ** (-jnp.arange(0, HEAD_DIM, 2, dtype=jnp.float32) / HEAD_DIM)
    ang = positions.astype(jnp.float32)[..., None] * inv_freq
    return jnp.cos(ang), jnp.sin(ang)


def apply_rope(x, cos, sin):
    x1, x2 = jnp.split(x.astype(jnp.float32), 2, axis=-1)
    c = cos[:, :, None, :]
    s = sin[:, :, None, :]
    return jnp.concatenate([x1 * c - x2 * s, x1 * s + x2 * c], axis=-1).astype(x.dtype)


def to_query_blocks(x):
    b, h, s, d = x.shape
    return x.reshape(b, h, s // Q_BLOCK, Q_BLOCK, d).transpose(2, 0, 1, 3, 4)


def from_query_blocks(o):
    nb, b, h, q, d = o.shape
    return o.transpose(1, 0, 3, 2, 4).reshape(b, nb * q, h * d)


def stick_breaking_attention(q, k, v):
    s = q.shape[2]
    scale = HEAD_DIM ** -0.5
    kpos = jnp.arange(s)
    starts = jnp.arange(s // Q_BLOCK) * Q_BLOCK

    def block(args):
        qb, start = args
        z = jnp.einsum('bhqd,bhkd->bhqk', qb, k).astype(jnp.float32) * scale
        qpos = start + jnp.arange(Q_BLOCK)
        valid = kpos[None, :] < qpos[:, None]
        log_fail = jnp.where(valid, jax.nn.log_sigmoid(-z), 0.0)
        incl = lax.cumsum(log_fail, axis=3, reverse=True)
        excl = jnp.concatenate([incl[..., 1:], jnp.zeros_like(incl[..., :1])], axis=-1)
        w = jnp.where(valid, jnp.exp(jax.nn.log_sigmoid(z) + excl), 0.0)
        return jnp.einsum('bhqk,bhkd->bhqd', w.astype(v.dtype), v)

    return from_query_blocks(lax.map(block, (to_query_blocks(q), starts)))


def differential_attention(q1, q2, k1, k2, v, lam):
    s = q1.shape[2]
    scale = HEAD_DIM ** -0.5
    kpos = jnp.arange(s)
    starts = jnp.arange(s // Q_BLOCK) * Q_BLOCK

    def block(args):
        q1b, q2b, start = args
        qpos = start + jnp.arange(Q_BLOCK)
        causal = kpos[None, :] <= qpos[:, None]

        def probs(qb, kk):
            sc = jnp.einsum('bhqd,bhkd->bhqk', qb, kk).astype(jnp.float32) * scale
            return jax.nn.softmax(jnp.where(causal, sc, -jnp.inf), axis=-1)

        p = probs(q1b, k1) - lam * probs(q2b, k2)
        return jnp.einsum('bhqk,bhkd->bhqd', p.astype(v.dtype), v)

    return from_query_blocks(lax.map(block, (to_query_blocks(q1), to_query_blocks(q2), starts)))


def peer_layer(h, w_q, sub_keys, u_tab, v_tab):
    b, s, d = h.shape
    t = h.reshape(b * s, d)
    n_tok = b * s
    q = (t @ w_q).reshape(n_tok, PEER_HEADS, 2, PEER_HALF)
    scores = jnp.einsum('thcd,hckd->thck', q, sub_keys).astype(jnp.float32)
    s_top, i_top = lax.top_k(scores, PEER_TOPK)
    cand = (s_top[:, :, 0, :, None] + s_top[:, :, 1, None, :]).reshape(n_tok, PEER_HEADS, PEER_TOPK * PEER_TOPK)
    cand_idx = (i_top[:, :, 0, :, None] * PEER_N_KEYS + i_top[:, :, 1, None, :]).reshape(n_tok, PEER_HEADS, PEER_TOPK * PEER_TOPK)
    best, pos = lax.top_k(cand, PEER_TOPK)
    idx = jnp.take_along_axis(cand_idx, pos, axis=-1)
    gate = jax.nn.softmax(best, axis=-1).astype(h.dtype)
    n_sel = PEER_HEADS * PEER_TOPK
    n_chunks = n_tok // PEER_CHUNK

    def chunk(args):
        tc, ic, gc = args
        act = jax.nn.gelu(jnp.einsum('cd,ced->ce', tc, u_tab[ic]), approximate=False)
        return jnp.einsum('ce,ced->cd', gc * act, v_tab[ic])

    out = lax.map(chunk, (t.reshape(n_chunks, PEER_CHUNK, d),
                          idx.reshape(n_chunks, PEER_CHUNK, n_sel),
                          gate.reshape(n_chunks, PEER_CHUNK, n_sel)))
    return out.reshape(b, s, d)


def setup_inputs(seed: int = 0) -> dict:
    key = jax.random.key(seed)
    ks = jax.random.split(key, 24)
    f32 = jnp.float32
    nrm = lambda k, shape, sc: jax.random.normal(k, shape, f32) * sc
    x = jax.random.normal(ks[0], (BATCH, SEQ, D_MODEL), f32)
    offsets = jax.random.randint(ks[1], (BATCH, 1), 0, 1024, dtype=jnp.int32)
    positions = offsets + jnp.arange(SEQ, dtype=jnp.int32)[None, :]
    col_scale = jnp.concatenate([
        jnp.ones((2 * SB_WIDTH,), f32), jnp.full((SB_WIDTH,), DEEPNORM_BETA, f32),
        jnp.ones((2 * DA_WIDTH,), f32), jnp.full((DA_WIDTH,), DEEPNORM_BETA, f32),
        jnp.ones((GATE_WIDTH,), f32)])
    w_in = nrm(ks[2], (DEPTH, D_MODEL, IN_WIDTH), D_MODEL ** -0.5) * col_scale
    b_gate = nrm(ks[3], (DEPTH, GATE_WIDTH), 0.02)
    lambda_q1 = nrm(ks[4], (DEPTH, HEAD_DIM), 0.1)
    lambda_k1 = nrm(ks[5], (DEPTH, HEAD_DIM), 0.1)
    lambda_q2 = nrm(ks[6], (DEPTH, HEAD_DIM), 0.1)
    lambda_k2 = nrm(ks[7], (DEPTH, HEAD_DIM), 0.1)
    subln_g = 1.0 + nrm(ks[8], (DEPTH, 2 * HEAD_DIM), 0.02)
    w_sb_branch = nrm(ks[9], (DEPTH, SB_WIDTH, D_MODEL), SB_WIDTH ** -0.5 * DEEPNORM_BETA)
    w_da_branch = nrm(ks[10], (DEPTH, DA_WIDTH, D_MODEL), DA_WIDTH ** -0.5 * DEEPNORM_BETA)
    w_out = nrm(ks[11], (DEPTH, D_MODEL, D_MODEL), D_MODEL ** -0.5 * DEEPNORM_BETA)
    ln1_g = 1.0 + nrm(ks[12], (DEPTH, D_MODEL), 0.02)
    ln1_b = nrm(ks[13], (DEPTH, D_MODEL), 0.02)
    peer_w_q = nrm(ks[14], (DEPTH, D_MODEL, PEER_HEADS * PEER_KEY_DIM), D_MODEL ** -0.5)
    peer_sub_keys = nrm(ks[15], (DEPTH, PEER_HEADS, 2, PEER_N_KEYS, PEER_HALF), PEER_HALF ** -0.5)
    peer_u = nrm(ks[16], (DEPTH, PEER_EXPERTS, D_MODEL), D_MODEL ** -0.5)
    peer_v = nrm(ks[17], (DEPTH, PEER_EXPERTS, D_MODEL), (PEER_HEADS * PEER_TOPK) ** -0.5 * DEEPNORM_BETA)
    ln2_g = 1.0 + nrm(ks[18], (DEPTH, D_MODEL), 0.02)
    ln2_b = nrm(ks[19], (DEPTH, D_MODEL), 0.02)
    return {"x": x, "positions": positions, "w_in": w_in, "b_gate": b_gate,
            "lambda_q1": lambda_q1, "lambda_k1": lambda_k1, "lambda_q2": lambda_q2, "lambda_k2": lambda_k2,
            "subln_g": subln_g, "w_sb_branch": w_sb_branch, "w_da_branch": w_da_branch, "w_out": w_out,
            "ln1_g": ln1_g, "ln1_b": ln1_b, "peer_w_q": peer_w_q, "peer_sub_keys": peer_sub_keys,
            "peer_u": peer_u, "peer_v": peer_v, "ln2_g": ln2_g, "ln2_b": ln2_b}


def reference(x, positions, w_in, b_gate, lambda_q1, lambda_k1, lambda_q2, lambda_k2, subln_g,
              w_sb_branch, w_da_branch, w_out, ln1_g, ln1_b, peer_w_q, peer_sub_keys, peer_u, peer_v,
              ln2_g, ln2_b):
    b, s, _ = x.shape
    cos, sin = rope_tables(positions)
    splits = [SB_WIDTH, 2 * SB_WIDTH, 3 * SB_WIDTH,
              3 * SB_WIDTH + DA_WIDTH, 3 * SB_WIDTH + 2 * DA_WIDTH, 3 * SB_WIDTH + 3 * DA_WIDTH]
    h = x
    for l in range(DEPTH):
        lam_init = 0.8 - 0.6 * math.exp(-0.3 * l)
        proj = h @ w_in[l]
        sb_q, sb_k, sb_v, da_q, da_k, da_v, gate_pre = jnp.split(proj, splits, axis=-1)

        heads = lambda t: t.reshape(b, s, SB_HEADS, HEAD_DIM).transpose(0, 2, 1, 3)
        o_sb = stick_breaking_attention(heads(sb_q), heads(sb_k), heads(sb_v))

        def qk_pair(t):
            t = apply_rope(t.reshape(b, s, 2 * DA_HEADS, HEAD_DIM), cos, sin)
            t = t.reshape(b, s, DA_HEADS, 2, HEAD_DIM).transpose(0, 2, 3, 1, 4)
            return t[:, :, 0], t[:, :, 1]
        q1, q2 = qk_pair(da_q)
        k1, k2 = qk_pair(da_k)
        v_da = da_v.reshape(b, s, DA_HEADS, 2 * HEAD_DIM).transpose(0, 2, 1, 3)
        lam = (jnp.exp(jnp.sum(lambda_q1[l].astype(jnp.float32) * lambda_k1[l].astype(jnp.float32)))
               - jnp.exp(jnp.sum(lambda_q2[l].astype(jnp.float32) * lambda_k2[l].astype(jnp.float32)))
               + lam_init)
        o_da = differential_attention(q1, q2, k1, k2, v_da, lam)
        o_da = (rms_norm(o_da.reshape(b, s, DA_HEADS, 2 * HEAD_DIM), subln_g[l]) * (1.0 - lam_init)).reshape(b, s, DA_WIDTH)

        g_sb, g_da = jnp.split(jax.nn.sigmoid(gate_pre + b_gate[l]), 2, axis=-1)
        merged = g_sb * (o_sb @ w_sb_branch[l]) + g_da * (o_da @ w_da_branch[l])
        mix = merged @ w_out[l]
        h = layer_norm(DEEPNORM_ALPHA * h + mix, ln1_g[l], ln1_b[l])

        ffn = peer_layer(h, peer_w_q[l], peer_sub_keys[l], peer_u[l], peer_v[l])
        h = layer_norm(DEEPNORM_ALPHA * h + ffn, ln2_g[l], ln2_b[l])
    return h
```

```cpp
#include <hip/hip_runtime.h>
#include <cstdio>
#include <cstdint>

constexpr int DM = 4096, NBATCH = 4, SEQ = 4096, T_TOK = NBATCH * SEQ;
constexpr int HD = 128, SB_HEADS = 16, DA_HEADS = 8, IN_W = 20480, GATE_W = 8192;
constexpr int P_HEADS = 8, P_KEYS = 128, P_TOPK = 16, P_SEL = 128, P_EXP = 16384;
constexpr float LN_EPS = 1e-5f;
constexpr float DN_ALPHA = 1.189207115002721f;
constexpr float LAM_INIT = 0.2f;
constexpr float QSCALE_SB = 0.08838834764831845f * 1.4426950408889634f;
typedef unsigned short bf16_t;

namespace pg8 {
#define PG8_LAS __attribute__((address_space(3)))
typedef unsigned short bf16_t;
typedef short bf16x8 __attribute__((ext_vector_type(8)));
typedef float f32x4 __attribute__((ext_vector_type(4)));
typedef unsigned u32x4 __attribute__((ext_vector_type(4)));
constexpr int BM = 256, BK = 64, HALF = 128, HTB = HALF * BK * 2  , STAGE_BYTES = 8 * HTB, NXCD = 8, WGM = 8;

__host__ __device__ __forceinline__ int lds_byte(int r, int c) { const int st = (r >> 4) * 2 + (c >> 5), rr = r & 15, cc = c & 31, ob = rr * 64 + cc * 2; return st * 1024 + (ob ^ (((ob >> 9) & 1) << 5)); }
__host__ __device__ __forceinline__ void stage_rc(int b, int& R, int& C) { const int st = b / 1024, sb = b % 1024, swz = sb ^ (((sb >> 9) & 1) << 5); R = (st >> 1) * 16 + swz / 64; C = (st & 1) * 32 + (swz % 64) / 2; }
__host__ __device__ __forceinline__ int perm32(int rho) { const int n = rho >> 4, i = rho & 15; return 8 * (i >> 2) + 4 * n + (i & 3); }

template <bool C, class A, class B> struct pg8_sel { typedef A type; };
template <class A, class B> struct pg8_sel<false, A, B> { typedef B type; };
struct Unit { int pm, pn; };
struct Gemm { const bf16_t* A; const bf16_t* Bt; int M, N, K; };

struct StaticOrder {
    int nM, nN, nwg, G, c;
    __host__ __device__ void init(int M, int N, int G_, int c_) { nM = M / BM; nN = N / BM; nwg = nM * nN; G = G_; c = c_; }
    __host__ __device__ bool next(int i, Unit& u) const {
        const long L = (long)i * G + c; if (L >= nwg) return false;
        int wgid = (int)L; { const int q = nwg / NXCD, r = nwg % NXCD, xcd = wgid % NXCD, off = wgid / NXCD; wgid = (xcd < r ? xcd * (q + 1) : r * (q + 1) + (xcd - r) * q) + off; }
        const int nig = WGM * nN, gid = wgid / nig, fm = gid * WGM, gsz = (nM - fm) < WGM ? (nM - fm) : WGM;
        u.pm = fm + ((wgid % nig) % gsz); u.pn = (wgid % nig) / gsz; return true;
    }
    __device__ __forceinline__ void a_ready(const Unit&) const {}
    __device__ __forceinline__ void done(const Unit&) const {}
};
typedef __bf16 nbf2_t __attribute__((ext_vector_type(2)));
typedef float nf2_t __attribute__((ext_vector_type(2)));
__device__ __forceinline__ unsigned cvt_pk_bf16(float lo, float hi) { const nf2_t v = {lo, hi}; const nbf2_t r = __builtin_convertvector(v, nbf2_t); return __builtin_bit_cast(unsigned, r); }
typedef float f32x2 __attribute__((ext_vector_type(2)));
__device__ __forceinline__ f32x2 gelu_pk(f32x2 v) {
    const f32x2 av = __builtin_elementwise_abs(v), d = av * 0.2316418882f + 1.0f;
    f32x2 t; t.x = __builtin_amdgcn_rcpf(d.x); t.y = __builtin_amdgcn_rcpf(d.y);
    f32x2 q = t * 0.5307027145f + (-0.7265760135f); q = q * t + 0.7107068705f; q = q * t + (-0.142248368f); q = q * t + 0.127414796f; q = q * t;
    const f32x2 s = (v * v) * (-0.72134752044f);
    f32x2 e; e.x = __builtin_amdgcn_exp2f(s.x); e.y = __builtin_amdgcn_exp2f(s.y);
    const f32x2 m = v * (q * e), r = v - m;
    f32x2 o; o.x = v.x < 0.f ? m.x : r.x; o.y = v.y < 0.f ? m.y : r.y; return o;
}
typedef unsigned u32x2_ __attribute__((ext_vector_type(2)));
__device__ __forceinline__ void unpack8(const u32x4 w, f32x4& a, f32x4& b) {
    a[0] = __uint_as_float(w.x << 16); a[1] = __uint_as_float(w.x & 0xffff0000u); a[2] = __uint_as_float(w.y << 16); a[3] = __uint_as_float(w.y & 0xffff0000u);
    b[0] = __uint_as_float(w.z << 16); b[1] = __uint_as_float(w.z & 0xffff0000u); b[2] = __uint_as_float(w.w << 16); b[3] = __uint_as_float(w.w & 0xffff0000u);
}
__device__ __forceinline__ u32x4 pack8f(const f32x4 v0, const f32x4 v1) { u32x4 w; w.x = cvt_pk_bf16(v0[0], v0[1]); w.y = cvt_pk_bf16(v0[2], v0[3]); w.z = cvt_pk_bf16(v1[0], v1[1]); w.w = cvt_pk_bf16(v1[2], v1[3]); return w; }
struct EpiProj {
    static constexpr bool PERM = true, AFTER_DRAIN = false;
    bf16_t* qkv; bf16_t* gate;   const float* bgate; const float* ropec; const float* ropes; const float* sx; const float* sw;
    __device__ __forceinline__ void operator()(const f32x4 (&acc)[2][2][4][2], const Unit& u, int wr, int wc, int fr, int fq) const {
        const int row0 = u.pm * BM + wr * 64 + fr;
        if (u.pn < 48) {
            const int type = u.pn >> 3, hb = (u.pn & 7) * 2;
            bf16_t* base = qkv + (size_t)type * ((size_t)T_TOK * 2048);
            const int b = u.pm >> 4, s0 = (u.pm & 15) * 256 + wr * 64 + fr, d0 = wc * 32 + 8 * fq;
            const bool rope = (type == 3) || (type == 4);
            const float sc = (type == 0) ? QSCALE_SB : 1.f;
            f32x4 cw[2][2];
#pragma unroll
            for (int bj = 0; bj < 2; ++bj)
#pragma unroll
                for (int n = 0; n < 2; ++n) cw[bj][n] = *(const f32x4*)(sw + u.pn * BM + bj * HALF + d0 + 4 * n);
#pragma unroll
            for (int ai = 0; ai < 2; ++ai)
#pragma unroll
                for (int m = 0; m < 4; ++m) {
                    const int s = s0 + ai * HALF + m * 16, row = row0 + ai * HALF + m * 16;
                    const float rs = sx[row] * sc;
                    f32x4 c4 = (f32x4){1.f, 1.f, 1.f, 1.f}, s4 = (f32x4){0.f, 0.f, 0.f, 0.f};
                    if (rope) { c4 = *(const f32x4*)(ropec + (size_t)row * 64 + 4 * (4 * wc + fq)); s4 = *(const f32x4*)(ropes + (size_t)row * 64 + 4 * (4 * wc + fq)); }
#pragma unroll
                    for (int bj = 0; bj < 2; ++bj) {
                        const f32x4 x1 = acc[ai][bj][m][0] * cw[bj][0], x2 = acc[ai][bj][m][1] * cw[bj][1];
                        const f32x4 r0 = (x1 * c4 - x2 * s4) * rs, r1 = (x1 * s4 + x2 * c4) * rs;
                        *(u32x4*)(base + ((size_t)((b * 16 + hb + bj) * SEQ + s)) * 128 + d0) = pack8f(r0, r1);
                    }
                }
        } else {
            const int gc0 = (u.pn - 48) * 256 + wc * 32 + 8 * fq;
            f32x4 bv[2][2], cw[2][2];
#pragma unroll
            for (int bj = 0; bj < 2; ++bj)
#pragma unroll
                for (int n = 0; n < 2; ++n) { bv[bj][n] = *(const f32x4*)(bgate + gc0 + bj * HALF + 4 * n); cw[bj][n] = *(const f32x4*)(sw + 12288 + gc0 + bj * HALF + 4 * n); }
#pragma unroll
            for (int ai = 0; ai < 2; ++ai)
#pragma unroll
                for (int m = 0; m < 4; ++m) {
                    unsigned char* rowp = (unsigned char*)gate + (size_t)(row0 + ai * HALF + m * 16) * GATE_W + gc0;
                    const float rs = sx[row0 + ai * HALF + m * 16];
#pragma unroll
                    for (int bj = 0; bj < 2; ++bj) {
                        f32x4 v0 = acc[ai][bj][m][0] * cw[bj][0] * rs + bv[bj][0], v1 = acc[ai][bj][m][1] * cw[bj][1] * rs + bv[bj][1];
#pragma unroll
                        for (int j = 0; j < 4; ++j) { v0[j] = __builtin_amdgcn_rcpf(1.f + __builtin_amdgcn_exp2f(-1.4426950408889634f * v0[j])); v1[j] = __builtin_amdgcn_rcpf(1.f + __builtin_amdgcn_exp2f(-1.4426950408889634f * v1[j])); }
                        unsigned lo_ = 0u, hi_ = 0u;
#pragma unroll
                        for (int j = 0; j < 4; ++j) { lo_ = __builtin_amdgcn_cvt_pk_u8_f32(v0[j] * 255.f, j, lo_); hi_ = __builtin_amdgcn_cvt_pk_u8_f32(v1[j] * 255.f, j, hi_); }
                        *(u32x2_*)(rowp + bj * HALF) = (u32x2_){lo_, hi_};
                    }
                }
        }
    }
};
template <int SECOND> struct EpiBranch {
    static constexpr bool PERM = true, AFTER_DRAIN = false;
    const bf16_t* gate; bf16_t* out; const float* sa; const float* sw; unsigned* rowmax;
    __device__ __forceinline__ void operator()(const f32x4 (&acc)[2][2][4][2], const Unit& u, int wr, int wc, int fr, int fq) const {
        const int row0 = u.pm * BM + wr * 64 + fr, col0 = u.pn * BM + wc * 32 + 8 * fq;
        f32x4 cw[2][2];
#pragma unroll
        for (int bj = 0; bj < 2; ++bj)
#pragma unroll
            for (int n = 0; n < 2; ++n) cw[bj][n] = *(const f32x4*)(sw + col0 + bj * HALF + 4 * n);
#pragma unroll
        for (int ai = 0; ai < 2; ++ai)
#pragma unroll
            for (int m = 0; m < 4; ++m) {
                const size_t row = (size_t)(row0 + ai * HALF + m * 16);
                const float rs = sa[row] * (1.f / 255.f); float rmx = 0.f;
#pragma unroll
                for (int bj = 0; bj < 2; ++bj) {
                    const int col = col0 + bj * HALF;
                    f32x4 ga, gb; { const u32x2_ gw_ = *(const u32x2_*)((const unsigned char*)gate + row * GATE_W + SECOND * DM + col);
#pragma unroll
                        for (int j = 0; j < 4; ++j) { ga[j] = (float)((gw_.x >> (8 * j)) & 255u); gb[j] = (float)((gw_.y >> (8 * j)) & 255u); } }
                    f32x4 v0 = acc[ai][bj][m][0] * cw[bj][0] * rs * ga, v1 = acc[ai][bj][m][1] * cw[bj][1] * rs * gb;
                    if (SECOND) { f32x4 pa, pb; unpack8(*(const u32x4*)(out + row * DM + col), pa, pb); v0 = v0 + pa; v1 = v1 + pb; }
                    *(u32x4*)(out + row * DM + col) = pack8f(v0, v1);
                    if (SECOND) { const f32x4 a0 = __builtin_elementwise_abs(v0), a1 = __builtin_elementwise_abs(v1);
                        rmx = fmaxf(rmx, fmaxf(fmaxf(fmaxf(a0[0], a0[1]), fmaxf(a0[2], a0[3])), fmaxf(fmaxf(a1[0], a1[1]), fmaxf(a1[2], a1[3])))); }
                }
                if (SECOND) { rmx = fmaxf(rmx, __shfl_xor(rmx, 16)); rmx = fmaxf(rmx, __shfl_xor(rmx, 32));
                    if (fq == 0) atomicMax(rowmax + row, __float_as_uint(rmx)); }
            }
    }
};
struct EpiResid {
    static constexpr bool PERM = false, AFTER_DRAIN = false;
    const float* x; float* y; const float* sa; const float* sw;
    __device__ __forceinline__ void operator()(const f32x4 (&acc)[2][2][4][2], const Unit& u, int wr, int wc, int fr, int fq) const {
        const int row0 = u.pm * BM + wr * 64 + fr, col0 = u.pn * BM + wc * 32 + 4 * fq;
        f32x4 cw[2][2];
#pragma unroll
        for (int bj = 0; bj < 2; ++bj)
#pragma unroll
            for (int n = 0; n < 2; ++n) cw[bj][n] = *(const f32x4*)(sw + col0 + bj * HALF + n * 16);
#pragma unroll
        for (int ai = 0; ai < 2; ++ai)
#pragma unroll
            for (int m = 0; m < 4; ++m) {
                const size_t off = (size_t)(row0 + ai * HALF + m * 16) * DM + col0; const float rs = sa[row0 + ai * HALF + m * 16];
#pragma unroll
                for (int bj = 0; bj < 2; ++bj)
#pragma unroll
                    for (int n = 0; n < 2; ++n) { const f32x4 xv = __builtin_nontemporal_load((const f32x4*)(x + off + bj * HALF + n * 16)); *(f32x4*)(y + off + bj * HALF + n * 16) = xv * DN_ALPHA + acc[ai][bj][m][n] * cw[bj][n] * rs; }
                asm volatile("" ::: "memory");
            }
    }
};
struct EpiF32 {
    static constexpr bool PERM = false, AFTER_DRAIN = false;
    float* C; int ldc; const float* sa; const float* sw;
    __device__ __forceinline__ void operator()(const f32x4 (&acc)[2][2][4][2], const Unit& u, int wr, int wc, int fr, int fq) const {
        const int row0 = u.pm * BM + wr * 64 + fr, col0 = u.pn * BM + wc * 32 + 4 * fq;
        f32x4 cw[2][2];
#pragma unroll
        for (int bj = 0; bj < 2; ++bj)
#pragma unroll
            for (int n = 0; n < 2; ++n) cw[bj][n] = *(const f32x4*)(sw + col0 + bj * HALF + n * 16);
#pragma unroll
        for (int ai = 0; ai < 2; ++ai)
#pragma unroll
            for (int m = 0; m < 4; ++m) { float* rowp = C + (size_t)(row0 + ai * HALF + m * 16) * ldc + col0; const float rs = sa[row0 + ai * HALF + m * 16];
#pragma unroll
                for (int bj = 0; bj < 2; ++bj)
#pragma unroll
                    for (int n = 0; n < 2; ++n) *(f32x4*)(rowp + bj * HALF + n * 16) = acc[ai][bj][m][n] * cw[bj][n] * rs; }
    }
};

template <class Epi, class Sched, bool ALIGN_EPI = false, bool SP2 = false, bool I8 = false>
__device__ __forceinline__ void gemm_phase(PG8_LAS unsigned char* lds, const Gemm g, const Sched& S, const Epi& E) {
    const int tid = threadIdx.x, wid = __builtin_amdgcn_readfirstlane(tid >> 6), lane = tid & 63, wr = wid >> 2, wc = wid & 3, fr = lane & 15, fq = lane >> 4;
    const int K = g.K, nt = K / BK;
    unsigned voffA[2], voffB[2];
#pragma unroll
    for (int i = 0; i < 2; ++i) { int R, C; stage_rc(tid * 16 + i * 8192, R, C); const int Rb = Epi::PERM ? ((R & ~31) + perm32(R & 31)) : R;
        voffA[i] = (unsigned)(R * K + C) * 2u; voffB[i] = (unsigned)(Rb * K + C) * 2u; }
    const size_t kstep = (size_t)(BK * 2);
    const size_t hstep = (size_t)HALF * K * 2;
    const size_t tstep = 2 * hstep;
    const unsigned ldsw = (unsigned)wid * 1024u;
    const int aoff = lds_byte(wr * 64 + fr, fq * 8), boff = lds_byte(wc * 32 + fr, fq * 8);
#define PG8_SA(b, h) (((b) * 2 + (h)) * HTB)
#define PG8_SB(b, h) ((4 + (b) * 2 + (h)) * HTB)
#define PG8_STAGE(bufoff, gbase, voff) do { _Pragma("unroll") for (int _i = 0; _i < 2; ++_i) \
        __builtin_amdgcn_global_load_lds((const unsigned*)((const char*)(gbase) + (voff)[_i]), (PG8_LAS unsigned*)(lds + (bufoff) + ldsw + _i * 8192), 16, 0, 0); } while (0)
#define PG8_LDA(dst, b, h) do { _Pragma("unroll") for (int m = 0; m < 4; ++m) _Pragma("unroll") for (int k = 0; k < 2; ++k) dst[m][k] = *(const PG8_LAS bf16x8*)(lds + PG8_SA(b, h) + aoff + m * 2048 + k * 1024); } while (0)
#define PG8_LDB(dst, b, h) do { _Pragma("unroll") for (int n = 0; n < 2; ++n) _Pragma("unroll") for (int k = 0; k < 2; ++k) dst[n][k] = *(const PG8_LAS bf16x8*)(lds + PG8_SB(b, h) + boff + n * 2048 + k * 1024); } while (0)
#define PG8_MMA(ai, bj, At, Bt) do { __builtin_amdgcn_s_setprio(1); _Pragma("unroll") for (int m = 0; m < 4; ++m) _Pragma("unroll") for (int n = 0; n < 2; ++n) _Pragma("unroll") for (int k = 0; k < 2; ++k) { \
        if constexpr (I8) acc[ai][bj][m][n] = __builtin_amdgcn_mfma_i32_16x16x64_i8(__builtin_bit_cast(i32x4, Bt[n][k]), __builtin_bit_cast(i32x4, At[m][k]), acc[ai][bj][m][n], 0, 0, 0); \
        else acc[ai][bj][m][n] = __builtin_amdgcn_mfma_f32_16x16x32_bf16(Bt[n][k], At[m][k], acc[ai][bj][m][n], 0, 0, 0); } __builtin_amdgcn_s_setprio(0); } while (0)
#define PG8_WAIT_V(n) asm volatile("s_waitcnt vmcnt(" #n ")" ::: "memory")
#define PG8_WAIT_L(n) asm volatile("s_waitcnt lgkmcnt(" #n ")" ::: "memory")
#define PG8_BAR __builtin_amdgcn_s_barrier()
#define PG8_SCHED __builtin_amdgcn_sched_barrier(0)
    Unit cur, nxt; int ui = 0;
    if (!S.next(0, cur)) return;
    typedef int i32x4 __attribute__((ext_vector_type(4)));
    typedef typename pg8_sel<I8, i32x4, f32x4>::type acc_t;
    acc_t acc[2][2][4][2];
#pragma unroll
    for (int a = 0; a < 2; ++a)
#pragma unroll
        for (int b = 0; b < 2; ++b)
#pragma unroll
            for (int m = 0; m < 4; ++m)
#pragma unroll
                for (int n = 0; n < 2; ++n) acc[a][b][m][n] = (acc_t){0, 0, 0, 0};
    bf16x8 At[4][2], B0[2][2], B1[2][2];
    const char* cA = (const char*)g.A + (size_t)cur.pm * tstep; const char* cB = (const char*)g.Bt + (size_t)cur.pn * tstep;
    S.a_ready(cur);
    if constexpr (SP2) {
        PG8_STAGE(PG8_SB(0, 0), cB, voffB); PG8_STAGE(PG8_SB(0, 1), cB + hstep, voffB); PG8_STAGE(PG8_SA(0, 0), cA, voffA); PG8_STAGE(PG8_SA(0, 1), cA + hstep, voffA);
        if (wr == 1) PG8_BAR;
        PG8_WAIT_V(2); PG8_BAR;
        PG8_STAGE(PG8_SB(1, 0), cB + kstep, voffB); PG8_STAGE(PG8_SA(1, 0), cA + kstep, voffA); PG8_STAGE(PG8_SB(1, 1), cB + hstep + kstep, voffB);
        PG8_WAIT_V(6); PG8_BAR;
    } else {
        PG8_STAGE(PG8_SB(0, 0), cB, voffB); PG8_STAGE(PG8_SA(0, 0), cA, voffA); PG8_STAGE(PG8_SB(0, 1), cB + hstep, voffB); PG8_STAGE(PG8_SA(0, 1), cA + hstep, voffA);
        if (wr == 1) PG8_BAR;
        PG8_WAIT_V(4); PG8_BAR;
        PG8_STAGE(PG8_SB(1, 0), cB + kstep, voffB); PG8_STAGE(PG8_SA(1, 0), cA + kstep, voffA); PG8_STAGE(PG8_SB(1, 1), cB + hstep + kstep, voffB);
        PG8_WAIT_V(6); PG8_BAR;
    }
    for (;;) {
        const bool has_next = S.next(ui + 1, nxt);
        const char* nA = has_next ? (const char*)g.A + (size_t)nxt.pm * tstep : cA; const char* nB = has_next ? (const char*)g.Bt + (size_t)nxt.pn * tstep : cB;
        for (int t = 0; t < nt; t += 2) {
            const bool last = (t == nt - 2);
            const char* a1 = cA + (size_t)(t + 1) * kstep;
            const char* a2 = last ? nA : cA + (size_t)(t + 2) * kstep; const char* b2 = last ? nB : cB + (size_t)(t + 2) * kstep;
            const char* a3 = a2 + kstep; const char* b3 = b2 + kstep;
            if (last && has_next) S.a_ready(nxt);
            if constexpr (SP2) {
            PG8_LDB(B0, 0, 0); PG8_LDB(B1, 0, 1); PG8_SCHED; PG8_LDA(At, 0, 0); PG8_STAGE(PG8_SA(1, 1), a1 + hstep, voffA);
            PG8_WAIT_V(8); PG8_WAIT_L(0); PG8_BAR; PG8_MMA(0, 0, At, B0); PG8_MMA(0, 1, At, B1); PG8_BAR; PG8_SCHED;
            PG8_LDA(At, 0, 1); PG8_STAGE(PG8_SB(0, 0), b2, voffB); PG8_STAGE(PG8_SB(0, 1), b2 + hstep, voffB); PG8_STAGE(PG8_SA(0, 0), a2, voffA);
            PG8_WAIT_V(8); PG8_WAIT_L(0); PG8_BAR; PG8_MMA(1, 0, At, B0); PG8_MMA(1, 1, At, B1); PG8_BAR; PG8_SCHED;
            PG8_LDB(B0, 1, 0); PG8_LDB(B1, 1, 1); PG8_SCHED; PG8_LDA(At, 1, 0); PG8_STAGE(PG8_SA(0, 1), a2 + hstep, voffA);
            PG8_WAIT_V(8); PG8_WAIT_L(0); PG8_BAR; PG8_MMA(0, 0, At, B0); PG8_MMA(0, 1, At, B1); PG8_BAR; PG8_SCHED;
            PG8_LDA(At, 1, 1); PG8_STAGE(PG8_SB(1, 0), b3, voffB); PG8_STAGE(PG8_SB(1, 1), b3 + hstep, voffB); PG8_STAGE(PG8_SA(1, 0), a3, voffA);
            PG8_WAIT_V(8); PG8_WAIT_L(0); PG8_BAR; PG8_MMA(1, 0, At, B0); PG8_MMA(1, 1, At, B1); PG8_BAR; PG8_SCHED;
            } else {
            PG8_LDB(B0, 0, 0); PG8_SCHED; PG8_LDA(At, 0, 0); PG8_STAGE(PG8_SA(1, 1), a1 + hstep, voffA);
            PG8_WAIT_L(8); PG8_BAR; PG8_WAIT_L(0); PG8_MMA(0, 0, At, B0); PG8_BAR; PG8_SCHED;
            PG8_LDB(B1, 0, 1); PG8_STAGE(PG8_SB(0, 0), b2, voffB);
            PG8_BAR; PG8_WAIT_L(0); PG8_MMA(0, 1, At, B1); PG8_BAR;
            PG8_LDA(At, 0, 1); PG8_STAGE(PG8_SA(0, 0), a2, voffA);
            PG8_BAR; PG8_WAIT_L(0); PG8_MMA(1, 0, At, B0); PG8_BAR; PG8_SCHED;
            PG8_STAGE(PG8_SB(0, 1), b2 + hstep, voffB);
            PG8_WAIT_V(6); PG8_BAR; PG8_MMA(1, 1, At, B1); PG8_BAR;
            PG8_LDB(B0, 1, 0); PG8_SCHED; PG8_LDA(At, 1, 0); PG8_STAGE(PG8_SA(0, 1), a2 + hstep, voffA);
            PG8_WAIT_L(8); PG8_BAR; PG8_WAIT_L(0); PG8_MMA(0, 0, At, B0); PG8_BAR; PG8_SCHED;
            PG8_LDB(B1, 1, 1); PG8_STAGE(PG8_SB(1, 0), b3, voffB);
            PG8_BAR; PG8_WAIT_L(0); PG8_MMA(0, 1, At, B1); PG8_BAR;
            PG8_LDA(At, 1, 1); PG8_STAGE(PG8_SA(1, 0), a3, voffA);
            PG8_BAR; PG8_WAIT_L(0); PG8_MMA(1, 0, At, B0); PG8_BAR; PG8_SCHED;
            PG8_STAGE(PG8_SB(1, 1), b3 + hstep, voffB);
            PG8_WAIT_V(6); PG8_BAR; PG8_MMA(1, 1, At, B1); PG8_BAR;
            }
        }
        if constexpr (ALIGN_EPI) { if (wr == 0) PG8_BAR; }
        if constexpr (!Epi::AFTER_DRAIN) {
            if constexpr (I8) { f32x4 accf[2][2][4][2];
#pragma unroll
                for (int a = 0; a < 2; ++a)
#pragma unroll
                    for (int b = 0; b < 2; ++b)
#pragma unroll
                        for (int m = 0; m < 4; ++m)
#pragma unroll
                            for (int n = 0; n < 2; ++n) accf[a][b][m][n] = __builtin_convertvector(acc[a][b][m][n], f32x4);
                E(accf, cur, wr, wc, fr, fq); }
            else E(acc, cur, wr, wc, fr, fq);
            S.done(cur); }
        if (!has_next) break;
#pragma unroll
        for (int a = 0; a < 2; ++a)
#pragma unroll
            for (int b = 0; b < 2; ++b)
#pragma unroll
                for (int m = 0; m < 4; ++m)
#pragma unroll
                    for (int n = 0; n < 2; ++n) acc[a][b][m][n] = (acc_t){0, 0, 0, 0};
        cur = nxt; cA = nA; cB = nB; ++ui;
        if constexpr (ALIGN_EPI) { if (wr == 1) PG8_BAR; }
    }
    PG8_WAIT_V(0);
    if constexpr (!ALIGN_EPI) { if (wr == 0) PG8_BAR; }
    PG8_BAR;
    static_assert(!Epi::AFTER_DRAIN, "no AFTER_DRAIN epilogue in this kernel");
#undef PG8_SA
#undef PG8_SB
#undef PG8_STAGE
#undef PG8_LDA
#undef PG8_LDB
#undef PG8_MMA
#undef PG8_WAIT_V
#undef PG8_WAIT_L
#undef PG8_BAR
#undef PG8_SCHED
}
}
#ifndef EXP_NOEXIT
#define EXP_NOEXIT 0
#endif
namespace att {
constexpr int D = 128, NW = 8, QBLK = 32, KVBLK = 64, QB = NW * QBLK;
constexpr int SHM_V = KVBLK * D * 2, SHM_K = KVBLK * D * 2;
constexpr int LDS_FLAGS = 2 * SHM_V + 2 * SHM_K + NW * 64 * 4;
constexpr int LDS_BYTES = LDS_FLAGS + 128;
constexpr float SCALE = 0.08838834764831845f, THR = 8.f, SB_THR = 48.f;
typedef short bf16x8 __attribute__((ext_vector_type(8)));
typedef short s16x4 __attribute__((ext_vector_type(4)));
typedef float f32x16 __attribute__((ext_vector_type(16)));
typedef float f32x4 __attribute__((ext_vector_type(4)));
typedef unsigned u32x4 __attribute__((ext_vector_type(4)));
#define KSWZ(row, colB) ((row) * 256 + ((colB) ^ (((row) & 7) << 4)))
#define SBAR() __builtin_amdgcn_sched_barrier(0)
__device__ __forceinline__ int v_st(int k, int c) { const int kk = (k & ~0xC) | ((k & 4) << 1) | ((k & 8) >> 1); return ((kk >> 3) * 4 + (c >> 5)) * 512 + ((kk & 7) * 32 + (c & 31)) * 2; }
__device__ __forceinline__ int v_rd_base(int lane) { return ((lane & 3) << 3) | (((lane >> 2) & 3) << 6) | (((lane >> 4) & 1) << 5) | (((lane >> 5) & 1) << 8); }
constexpr int v_rd_off(int d0, int ks, int half) { return d0 * 512 + ks * 4096 + half * 2048; }
__device__ __forceinline__ int crow(int r, int hi) { return (r & 3) + 8 * (r >> 2) + 4 * hi; }
__device__ __forceinline__ unsigned cvtpk(float lo, float hi) { return pg8::cvt_pk_bf16(lo, hi); }
__device__ __forceinline__ bf16x8 load8(const bf16_t* p) { return *reinterpret_cast<const bf16x8*>(p); }
__device__ __forceinline__ bf16x8 load8o(const bf16_t* base, unsigned boff) { return *reinterpret_cast<const bf16x8*>(reinterpret_cast<const char*>(base) + boff); }
__device__ __forceinline__ void mask_tile(f32x16& p0, f32x16& p1, int dq, unsigned W) {
    const float NEG = -__builtin_inff();
#pragma unroll
    for (int r = 0; r < 16; ++r) {
        const int c = (r & 3) + 8 * (r >> 2);
        if ((unsigned)(dq - c) >= W) p0[r] = NEG;
        if ((unsigned)(dq - c - 32) >= W) p1[r] = NEG;
    }
}
__device__ __forceinline__ void partialSM(f32x16& p0, f32x16& p1, float& m_reg, float& mn, float& alpha) {
    float pmax = p0[0]; for (int r = 1; r < 16; ++r) pmax = fmaxf(pmax, p0[r]); for (int r = 0; r < 16; ++r) pmax = fmaxf(pmax, p1[r]);
    { auto rr = __builtin_amdgcn_permlane32_swap(__float_as_uint(pmax), __float_as_uint(pmax), false, false);
      pmax = fmaxf(__uint_as_float(rr[0]), __uint_as_float(rr[1])); }
    constexpr float C2 = 1.4426950408889634f * SCALE;
    if (__builtin_expect(__all((pmax - m_reg) * SCALE <= THR), 1)) { mn = m_reg; alpha = 1.f; }
    else { mn = fmaxf(m_reg, pmax); alpha = __builtin_amdgcn_exp2f((m_reg - mn) * C2); m_reg = mn; }
    const float mnL = -mn * C2;
    for (int r = 0; r < 16; ++r) p0[r] = fmaf(p0[r], C2, mnL); for (int r = 0; r < 16; ++r) p1[r] = fmaf(p1[r], C2, mnL);
    for (int r = 0; r < 16; ++r) p0[r] = __builtin_amdgcn_exp2f(p0[r]);
}
#define PK4(P, B_, OUT) do { unsigned a0 = cvtpk(P[B_+0], P[B_+1]), a1 = cvtpk(P[B_+2], P[B_+3]);                          \
        unsigned b0 = cvtpk(P[B_+4], P[B_+5]), b1 = cvtpk(P[B_+6], P[B_+7]);                                             \
        auto r0 = __builtin_amdgcn_permlane32_swap(a0, b0, false, false); auto r1 = __builtin_amdgcn_permlane32_swap(a1, b1, false, false); \
        u32x4 w = {r0[0], r1[0], r0[1], r1[1]}; OUT = *reinterpret_cast<bf16x8*>(&w); } while (0)
__device__ __forceinline__ void finishSM(f32x16& p0, f32x16& p1, float alpha, float& l_reg, bf16x8& pa0, bf16x8& pa1, bf16x8& pa2, bf16x8& pa3) {
    for (int r = 0; r < 16; ++r) p1[r] = __builtin_amdgcn_exp2f(p1[r]);
    float ps = 0; for (int r = 0; r < 16; ++r) ps += p0[r]; for (int r = 0; r < 16; ++r) ps += p1[r];
    { auto rr = __builtin_amdgcn_permlane32_swap(__float_as_uint(ps), __float_as_uint(ps), false, false);
      ps = __uint_as_float(rr[0]) + __uint_as_float(rr[1]); }
    l_reg = l_reg * alpha + ps;
    PK4(p0, 0, pa0); PK4(p0, 8, pa1); PK4(p1, 0, pa2); PK4(p1, 8, pa3);
}
__device__ __forceinline__ float sp2f(float z) { return fmaxf(z, 0.f) + __builtin_amdgcn_logf(1.f + __builtin_amdgcn_exp2f(-__builtin_fabsf(z))); }
__device__ __forceinline__ void sb_group(float& z0, float& z1, float& z2, float& z3, float& suf, int hi) {
    asm volatile("" : "+v"(suf), "+v"(z0), "+v"(z1), "+v"(z2), "+v"(z3));
    const float s0 = sp2f(z0), s1 = sp2f(z1), s2 = sp2f(z2), s3 = sp2f(z3);
    const float G = (s0 + s1) + (s2 + s3);
    auto rr = __builtin_amdgcn_permlane32_swap(__float_as_uint(G), __float_as_uint(G), false, false);
    const float oth = hi ? __uint_as_float(rr[0]) : __uint_as_float(rr[1]);
    float run = suf + (hi ? 0.f : oth);
    run += s3; z3 -= run; run += s2; z2 -= run; run += s1; z1 -= run; run += s0; z0 -= run;
    suf += hi ? (oth + G) : (G + oth);
}
__device__ __forceinline__ void sb_partial(f32x16& p0, f32x16& p1, float& R, int hi) {
#pragma unroll
    for (int i = 3; i >= 0; --i) { float a = p1[4 * i], b = p1[4 * i + 1], c = p1[4 * i + 2], d = p1[4 * i + 3]; sb_group(a, b, c, d, R, hi); p1[4 * i] = a; p1[4 * i + 1] = b; p1[4 * i + 2] = c; p1[4 * i + 3] = d; }
#pragma unroll
    for (int i = 3; i >= 0; --i) { float a = p0[4 * i], b = p0[4 * i + 1], c = p0[4 * i + 2], d = p0[4 * i + 3]; sb_group(a, b, c, d, R, hi); p0[4 * i] = a; p0[4 * i + 1] = b; p0[4 * i + 2] = c; p0[4 * i + 3] = d; }
}
__device__ __forceinline__ void sb_finish(f32x16& p0, f32x16& p1, bf16x8& pa0, bf16x8& pa1, bf16x8& pa2, bf16x8& pa3) {
    for (int r = 0; r < 16; ++r) p0[r] = __builtin_amdgcn_exp2f(p0[r]);
    for (int r = 0; r < 16; ++r) p1[r] = __builtin_amdgcn_exp2f(p1[r]);
    PK4(p0, 0, pa0); PK4(p0, 8, pa1); PK4(p1, 0, pa2); PK4(p1, 8, pa3);
}
#undef PK4
#ifdef EXP_NOPART
#define SBX_PARTIAL(a,b,c,d) do { (c) += (a)[0]; } while (0)
#else
#define SBX_PARTIAL(a,b,c,d) sb_partial(a,b,c,d)
#endif
template <int KB>
__device__ __forceinline__ void qkt(f32x16& p0, f32x16& p1, const char* K_lds, int r32, int hi, const bf16x8* qr) {
    p0 = f32x16{}; p1 = f32x16{};
    const char* kb[4];
#pragma unroll
    for (int dd = 0; dd < 4; ++dd) kb[dd] = K_lds + KB * SHM_K + KSWZ(r32, (dd * 16 + hi * 8) * 2);
#pragma unroll
    for (int d0 = 0; d0 < 8; ++d0) { const char* a = kb[d0 & 3] + (d0 >> 2) * 128;
        bf16x8 b0 = *reinterpret_cast<const bf16x8*>(a);
        bf16x8 b1 = *reinterpret_cast<const bf16x8*>(a + 32 * 256);
        p0 = __builtin_amdgcn_mfma_f32_32x32x16_bf16(b0, qr[d0], p0, 0, 0, 0);
        p1 = __builtin_amdgcn_mfma_f32_32x32x16_bf16(b1, qr[d0], p1, 0, 0, 0); }
}
template <int VB>
__device__ __forceinline__ void pv_tile(f32x16* o, int vb0, bf16x8 pa0, bf16x8 pa1, bf16x8 pa2, bf16x8 pa3) {
#define TRRD(dst, off) asm volatile("ds_read_b64_tr_b16 %0, %1 offset:%2" : "=&v"(dst) : "v"(vb0), "i"(off) : "memory")
#define PV_D0(d0) do { s16x4 l0, l1, l2, l3, h0, h1, h2, h3; constexpr int b_ = VB * SHM_V + v_rd_off(d0, 0, 0); \
        TRRD(l0, b_); TRRD(h0, b_ + 2048); TRRD(l1, b_ + 4096); TRRD(h1, b_ + 6144); TRRD(l2, b_ + 8192); TRRD(h2, b_ + 10240); TRRD(l3, b_ + 12288); TRRD(h3, b_ + 14336); \
        asm volatile("s_waitcnt lgkmcnt(0)" ::: "memory"); SBAR();   \
        o[d0] = __builtin_amdgcn_mfma_f32_32x32x16_bf16(pa0, (bf16x8){l0[0], l0[1], l0[2], l0[3], h0[0], h0[1], h0[2], h0[3]}, o[d0], 0, 0, 0);   \
        o[d0] = __builtin_amdgcn_mfma_f32_32x32x16_bf16(pa1, (bf16x8){l1[0], l1[1], l1[2], l1[3], h1[0], h1[1], h1[2], h1[3]}, o[d0], 0, 0, 0);   \
        o[d0] = __builtin_amdgcn_mfma_f32_32x32x16_bf16(pa2, (bf16x8){l2[0], l2[1], l2[2], l2[3], h2[0], h2[1], h2[2], h2[3]}, o[d0], 0, 0, 0);   \
        o[d0] = __builtin_amdgcn_mfma_f32_32x32x16_bf16(pa3, (bf16x8){l3[0], l3[1], l3[2], l3[3], h3[0], h3[1], h3[2], h3[3]}, o[d0], 0, 0, 0); } while (0)
    PV_D0(0); PV_D0(1); PV_D0(2); PV_D0(3);
#undef PV_D0
#undef TRRD
}
struct BlockRef { const bf16_t* Q; const bf16_t* K; const bf16_t* V; bf16_t* O; int P0; };
struct Seam { bf16x8 qr[8]; bf16x8 st_v0, st_v1, st_k0, st_k1; };
template <int MODE> __device__ __forceinline__ int first_tile(int P0) { return MODE == 1 ? (P0 + QB - 1) / KVBLK : 0; }
#define ROWB(k0, rr) ((unsigned)((((k0) + (rr)) * D + sc) * 2))
#define VMW() asm volatile("s_waitcnt vmcnt(0)" ::: "memory")
#define VMWN(n) asm volatile("s_waitcnt vmcnt(%0)" :: "i"(n) : "memory")
#define SLOAD_H(Kp, Vp, k0) do { S.st_v0 = load8o(Vp, ROWB(k0, sr)); S.st_v1 = load8o(Vp, ROWB(k0, 32 + sr));              \
                         S.st_k0 = load8o(Kp, ROWB(k0, sr)); S.st_k1 = load8o(Kp, ROWB(k0, 32 + sr)); } while (0)
#define SWRITE_HK(bf) do { *(bf16x8*)(K_lds + (bf) * SHM_K + kws) = S.st_k0; *(bf16x8*)(K_lds + (bf) * SHM_K + kws + 32 * 256) = S.st_k1; } while (0)
#define SWRITE_HV(bf) do { *(bf16x8*)(V_lds + (bf) * SHM_V + vst0) = S.st_v0; *(bf16x8*)(V_lds + (bf) * SHM_V + vst1) = S.st_v1; } while (0)
#define SWRITE_H(bf) do { SWRITE_HV(bf); SWRITE_HK(bf); } while (0)
template <int MODE>
__device__ __forceinline__ void attn_prime(const BlockRef& cur, char* lds, Seam& S, const int tid) {
    const int  wid = __builtin_amdgcn_readfirstlane(tid >> 6), lane = tid & 63, r32 = lane & 31, hi = lane >> 5;
    const int sr = tid >> 4, sc = (tid & 15) * 8, kws = KSWZ(sr, sc * 2); char* K_lds = lds + 2 * SHM_V;
    const int kb0 = first_tile<MODE>(cur.P0) * KVBLK;
    for (int d0 = 0; d0 < 8; ++d0) S.qr[d0] = load8o(cur.Q, (unsigned)(((wid * QBLK + r32) * D + d0 * 16 + hi * 8) * 2));
    SLOAD_H(cur.K, cur.V, kb0); VMW(); SWRITE_HK(0);
    __syncthreads();
}
template <int MODE>
__device__ __forceinline__ void attn_block(const BlockRef& cur, const BlockRef& nxt, int  , char* lds, Seam& S, const int tid) {
    constexpr int ldo = 2048;
    const int  wid = __builtin_amdgcn_readfirstlane(tid >> 6), lane = tid & 63, r32 = lane & 31, hi = lane >> 5;
    const int j_hi = (cur.P0 + QB - 1) / KVBLK + 1;
    int NT = j_hi;
    const int kbn = first_tile<MODE>(nxt.P0) * KVBLK;
    const int qlo = cur.P0 + wid * QBLK, qm = qlo + r32 - 4 * hi;
    char* V_lds = lds; char* K_lds = lds + 2 * SHM_V;
    float* ws = (float*)(lds + 2 * SHM_V + 2 * SHM_K) + wid * 64; float* li_l = ws, * al_l = ws + 32;
    __attribute__((address_space(3))) int* flags = (__attribute__((address_space(3))) int*)(lds + LDS_FLAGS);
    float m_reg = -1e30f, l_reg = 0; f32x16 o[4] = {};
    float Rc = 0.f;
    const int sr = tid >> 4, sc = (tid & 15) * 8, vst0 = v_st(sr, sc), vst1 = vst0 + 8192  , kws = KSWZ(sr, sc * 2);
    const int vb0 = (int)(uintptr_t)V_lds + v_rd_base(lane);
    const bf16_t* Kh = cur.K; const bf16_t* Vh = cur.V;
#define RESC(a) do { if (MODE == 0) { if (__any((a) < 1.f)) { if (hi == 0) al_l[r32] = (a); asm volatile("s_waitcnt lgkmcnt(0)" ::: "memory");              \
                     for (int d_ = 0; d_ < 4; ++d_) for (int r = 0; r < 16; ++r) o[d_][r] *= al_l[crow(r, hi)]; } } } while (0)
#define KBASE(t) ((MODE == 1 ? (j_hi - 1 - (t)) : (t)) * KVBLK)
#define MASKT(P0_, P1_, t) do { const int kb_ = KBASE(t); if (MODE == 0) { if (kb_ + KVBLK - 1 > qlo) mask_tile(P0_, P1_, qm - kb_, 0x40000000u); }             \
                                else { if (kb_ + KVBLK - 1 >= qlo) mask_tile(P0_, P1_, qm - 1 - kb_, 0x40000000u); } } while (0)
#define PART(P0_, P1_, mnX, alX, fs) do { if (MODE == 0) partialSM(P0_, P1_, m_reg, mnX, alX); else { SBAR(); SBX_PARTIAL(P0_, P1_, Rc, hi); \
                                      const int dn_ = __all(Rc > SB_THR) ? 1 : 0; if (lane == 0) flags[(fs) * 8 + wid] = dn_; } } while (0)
#define FIN(P0_, P1_, alY) do { if (MODE == 0) finishSM(P0_, P1_, alY, l_reg, pa0, pa1, pa2, pa3); else sb_finish(P0_, P1_, pa0, pa1, pa2, pa3); } while (0)
    constexpr int NQL = 8;
#define SEAM_K0() do { VMWN(NQL); SWRITE_HK(0); SBAR(); } while (0)
    f32x16 pA0, pA1, pB0, pB1; float mnA = 0.f, mnB = 0.f, alA = 1.f, alB = 1.f; bf16x8 pa0, pa1, pa2, pa3;
    SWRITE_HV(0); SBAR();
    if (NT > 1) SLOAD_H(Kh, Vh, KBASE(1));
    SBAR(); qkt<0>(pA0, pA1, K_lds, r32, hi, S.qr);
    MASKT(pA0, pA1, 0); PART(pA0, pA1, mnA, alA, 2);
    if (NT > 1) { VMW(); SWRITE_H(1); }
    __syncthreads();
#define HALF_STEP(PX0, PX1, mnX, alX, PY0, PY1, alY, t, KB, VB, SB, fs) do {                                                      \
        SBAR(); qkt<KB>(PX0, PX1, K_lds, r32, hi, S.qr);                                                                     \
        FIN(PY0, PY1, alY); SBAR();                                                                                           \
        if ((t) + 1 < NT) { SLOAD_H(Kh, Vh, KBASE((t) + 1)); SBAR(); }                                                        \
        pv_tile<VB>(o, vb0, pa0, pa1, pa2, pa3); MASKT(PX0, PX1, (t)); PART(PX0, PX1, mnX, alX, fs);                          \
        __syncthreads();                                                                                                      \
        if ((t) + 1 < NT) { VMW(); SWRITE_H(SB); }                                                                            \
        RESC(alX); __syncthreads(); } while (0)
    for (int t = 1; t + 1 < NT; t += 2) {
        const int fsl = (t >> 1) & 1;
        HALF_STEP(pB0, pB1, mnB, alB, pA0, pA1, alA, t, 1, 0, 0, 2);
        HALF_STEP(pA0, pA1, mnA, alA, pB0, pB1, alB, t + 1, 0, 1, 1, fsl);
        if (MODE == 1 && !EXP_NOEXIT) {
            typedef int v4i_ __attribute__((ext_vector_type(4)));
            const __attribute__((address_space(3))) v4i_* f_ = (const __attribute__((address_space(3))) v4i_*)(lds + LDS_FLAGS + fsl * 32);
            const v4i_ fa_ = f_[0], fb_ = f_[1];
            const int all_ = __builtin_amdgcn_readfirstlane((fa_.x & fa_.y & fa_.z & fa_.w) & (fb_.x & fb_.y & fb_.z & fb_.w));
#ifdef EXP_FAKEALL
            if (cur.P0 == 12345 + t) NT = t + 2;
#else
            if (all_) NT = t + 2;
#endif
        }
    }
    const bool even = (NT & 1) == 0;
    if (even) { SBAR(); qkt<1>(pB0, pB1, K_lds, r32, hi, S.qr); SBAR(); }
    SLOAD_H(nxt.K, nxt.V, kbn); SBAR();
#pragma unroll
    for (int d0 = 0; d0 < 8; ++d0) S.qr[d0] = load8o(nxt.Q, (unsigned)(((wid * QBLK + r32) * D + d0 * 16 + hi * 8) * 2));
    SBAR();
    FIN(pA0, pA1, alA); SBAR();
    pv_tile<0>(o, vb0, pa0, pa1, pa2, pa3);
    if (even) { MASKT(pB0, pB1, NT - 1); PART(pB0, pB1, mnB, alB, 2); __syncthreads(); RESC(alB);
        FIN(pB0, pB1, alB); SBAR(); pv_tile<1>(o, vb0, pa0, pa1, pa2, pa3); }
    SBAR(); SEAM_K0();
    float rli[16];
    if (MODE == 0) { if (hi == 0) li_l[r32] = l_reg; asm volatile("s_waitcnt lgkmcnt(0)" ::: "memory");
#pragma unroll
        for (int r = 0; r < 16; ++r) rli[r] = __builtin_amdgcn_rcpf(li_l[crow(r, hi)]); }
    else {
#pragma unroll
        for (int r = 0; r < 16; ++r) rli[r] = 1.f; }
    const unsigned obase = (unsigned)((wid * QBLK + 4 * hi) * ldo + r32);
#pragma unroll
    for (int r = 0; r < 16; ++r) { const int orow0 = (r & 3) + 8 * (r >> 2);
#pragma unroll
        for (int d0 = 0; d0 < 4; ++d0) { const float v = o[d0][r] * rli[r];
            const float vn = __shfl_xor(v, 1);
            if ((r32 & 1) == 0) *(unsigned*)(reinterpret_cast<char*>(cur.O) + ((obase + (unsigned)(orow0 * ldo + d0 * 32)) * 2u)) = cvtpk(v, vn); } }
    __syncthreads();
#undef RESC
#undef KBASE
#undef MASKT
#undef PART
#undef FIN
#undef SEAM_K0
#undef HALF_STEP
}
constexpr int VS_QB = 128;
constexpr int VS_K = 4 * SHM_V, VS_P = VS_K + 2 * SHM_K, VS_SMALL = 131072 + 4096;
static_assert(VS_P + 4 * 2 * 4096 <= 131072, "LDS map of the shared-softmax attention");
struct BlockRefVS { const bf16_t* Q; const bf16_t* K; const bf16_t* Vlo; bf16_t* O; int P0; };
#define VSBAR() do { asm volatile("s_waitcnt lgkmcnt(0)" ::: "memory"); __builtin_amdgcn_s_barrier(); asm volatile("" ::: "memory"); } while (0)
__device__ __forceinline__ void vs_store(const f32x16* o, const float* li_w, bf16_t* O, int pw, int r32, int hi, int coff) {
    constexpr int ldo = 2048;
    float rli[16];
#pragma unroll
    for (int r = 0; r < 16; ++r) rli[r] = __builtin_amdgcn_rcpf(li_w[crow(r, hi)]);
    const unsigned obase = (unsigned)((pw * QBLK + 4 * hi) * ldo + r32 + coff);
#pragma unroll
    for (int r = 0; r < 16; ++r) { const int orow0 = (r & 3) + 8 * (r >> 2);
#pragma unroll
        for (int d0 = 0; d0 < 4; ++d0) { const float v = o[d0][r] * rli[r];
            const float vn = __builtin_bit_cast(float, __builtin_amdgcn_update_dpp(0, __builtin_bit_cast(int, v), 0xB1, 0xF, 0xF, true));
            if ((r32 & 1) == 0) *(unsigned*)(reinterpret_cast<char*>(O) + ((obase + (unsigned)(orow0 * ldo + d0 * 32)) * 2u)) = cvtpk(v, vn); } }
}
__device__ __forceinline__ void partialSM_bf(f32x16& p0, f32x16& p1, float& m_reg, float& alpha) {
    float pmax = p0[0]; for (int r = 1; r < 16; ++r) pmax = fmaxf(pmax, p0[r]); for (int r = 0; r < 16; ++r) pmax = fmaxf(pmax, p1[r]);
    { auto rr = __builtin_amdgcn_permlane32_swap(__float_as_uint(pmax), __float_as_uint(pmax), false, false);
      pmax = fmaxf(__uint_as_float(rr[0]), __uint_as_float(rr[1])); }
    constexpr float C2 = 1.4426950408889634f * SCALE;
    const float mn = ((pmax - m_reg) * SCALE <= THR) ? m_reg : fmaxf(m_reg, pmax);
    alpha = __builtin_amdgcn_exp2f((m_reg - mn) * C2); m_reg = mn;
    const float mnL = -mn * C2;
    for (int r = 0; r < 16; ++r) p0[r] = fmaf(p0[r], C2, mnL); for (int r = 0; r < 16; ++r) p1[r] = fmaf(p1[r], C2, mnL);
    for (int r = 0; r < 16; ++r) p0[r] = __builtin_amdgcn_exp2f(p0[r]);
}
__device__ __forceinline__ void vs_producer(const BlockRefVS& cur, char* lds, int pw, int lane, int pt, int NT) {
    const int r32 = lane & 31, hi = lane >> 5;
    const int qlo = cur.P0 + pw * QBLK, qm = qlo + r32 - 4 * hi;
    char* K_lds = lds + VS_K; char* P_w = lds + VS_P + pw * 8192;
    const int sr = pt >> 4, sc = (pt & 15) * 8, kws = KSWZ(sr, sc * 2); const unsigned rof0 = ROWB(0, sr); const bf16_t* Kh = cur.K;
    bf16x8 st_k[4];
#define PLOADK(t) do { const size_t to_ = (size_t)(t) * (KVBLK * D); _Pragma("unroll") for (int i_ = 0; i_ < 4; ++i_) st_k[i_] = load8o(Kh + to_, rof0 + i_ * (16 * D * 2)); } while (0)
#define PWRITEK(bf) do { _Pragma("unroll") for (int i_ = 0; i_ < 4; ++i_) *(bf16x8*)(K_lds + (bf) * SHM_K + kws + i_ * (16 * 256)) = st_k[i_]; } while (0)
    float* al_w = (float*)(lds + VS_SMALL) + pw * 128; float* li_w = al_w + 64; float* fl_w = al_w + 96;
    float m_reg = -1e30f, l_reg = 0;
    bf16x8 qr[8]; f32x16 pA0, pA1, pB0, pB1; float al = 1.f; bf16x8 pa0, pa1, pa2, pa3;
    PLOADK(0); VMW(); PWRITEK(0); PLOADK(1); VMW(); PWRITEK(1); if (2 < NT) PLOADK(2);
    for (int d0 = 0; d0 < 8; ++d0) qr[d0] = load8o(cur.Q, (unsigned)(((pw * QBLK + r32) * D + d0 * 16 + hi * 8) * 2));
    VSBAR();
    qkt<0>(pA0, pA1, K_lds, r32, hi, qr);
    VSBAR();
#define PX(t, TP, C0, C1, N0, N1, DO_NEXT) do { SBAR(); VMW(); if ((t) + 2 < NT) PWRITEK(TP); if ((t) + 3 < NT) PLOADK((t) + 3); SBAR();     \
        { const int kb_ = (t) * KVBLK; if (kb_ + KVBLK - 1 > qlo) mask_tile(C0, C1, qm - kb_, 0x40000000u); }                                             \
        SBAR();                                                                                                                                        \
        if (DO_NEXT) qkt<1 - (TP)>(N0, N1, K_lds, r32, hi, qr);                                                                                        \
        partialSM_bf(C0, C1, m_reg, al); finishSM(C0, C1, al, l_reg, pa0, pa1, pa2, pa3);                                                              \
        _Pragma("unroll") for (int g_ = 0; g_ < 16; ++g_) { __builtin_amdgcn_sched_group_barrier(0x008, 1, 0); __builtin_amdgcn_sched_group_barrier(0x002, 16, 0); }     \
        SBAR();                                                                                                                                        \
        { bf16x8* pb_ = (bf16x8*)(P_w + (TP) * 4096) + lane; pb_[0] = pa0; pb_[64] = pa1; pb_[128] = pa2; pb_[192] = pa3; }                            \
        { const int any_ = __any(al < 1.f) ? 1 : 0; if (hi == 0) al_w[(TP) * 32 + r32] = al; if (lane == 0) fl_w[TP] = (float)any_; }                   \
        if ((t) + 1 == NT) { if (hi == 0) li_w[r32] = l_reg; }                                                                                         \
        SBAR(); VSBAR(); } while (0)
    for (int t = 0; t + 2 < NT; t += 2) { PX(t, 0, pA0, pA1, pB0, pB1, true); PX(t + 1, 1, pB0, pB1, pA0, pA1, true); }
    PX(NT - 2, 0, pA0, pA1, pB0, pB1, true); PX(NT - 1, 1, pB0, pB1, pA0, pA1, false);
#undef PX
#undef PLOADK
#undef PWRITEK
}
template <int PB>
__device__ __forceinline__ void pv8(f32x16* ol, f32x16* oh, int vb0, bf16x8 pa0, bf16x8 pa1, bf16x8 pa2, bf16x8 pa3) {
#define TRRD(dst, off) asm volatile("ds_read_b64_tr_b16 %0, %1 offset:%2" : "=&v"(dst) : "v"(vb0), "i"(off) : "memory")
#define LGKW(n) do { asm volatile("s_waitcnt lgkmcnt(%0)" :: "i"(n) : "memory"); SBAR(); } while (0)
#define VB8(g) ((((g) < 4 ? PB : 2 + PB)) * SHM_V + v_rd_off((g) & 3, 0, 0))
#define VRD8(L, H, g) do { _Pragma("unroll") for (int i_ = 0; i_ < 4; ++i_) { TRRD(L[i_], VB8(g) + i_ * 4096); TRRD(H[i_], VB8(g) + i_ * 4096 + 2048); } } while (0)
#define PVM8(L, H, ACC) do { ACC = __builtin_amdgcn_mfma_f32_32x32x16_bf16(pa0, (bf16x8){L[0][0], L[0][1], L[0][2], L[0][3], H[0][0], H[0][1], H[0][2], H[0][3]}, ACC, 0, 0, 0); \
        ACC = __builtin_amdgcn_mfma_f32_32x32x16_bf16(pa1, (bf16x8){L[1][0], L[1][1], L[1][2], L[1][3], H[1][0], H[1][1], H[1][2], H[1][3]}, ACC, 0, 0, 0); \
        ACC = __builtin_amdgcn_mfma_f32_32x32x16_bf16(pa2, (bf16x8){L[2][0], L[2][1], L[2][2], L[2][3], H[2][0], H[2][1], H[2][2], H[2][3]}, ACC, 0, 0, 0); \
        ACC = __builtin_amdgcn_mfma_f32_32x32x16_bf16(pa3, (bf16x8){L[3][0], L[3][1], L[3][2], L[3][3], H[3][0], H[3][1], H[3][2], H[3][3]}, ACC, 0, 0, 0); SBAR(); } while (0)
    s16x4 la[4], ha[4], lb[4], hb[4];
    VRD8(la, ha, 0);
    VRD8(lb, hb, 1); LGKW(8); PVM8(la, ha, ol[0]);
    VRD8(la, ha, 2); LGKW(8); PVM8(lb, hb, ol[1]);
    VRD8(lb, hb, 3); LGKW(8); PVM8(la, ha, ol[2]);
    VRD8(la, ha, 4); LGKW(8); PVM8(lb, hb, ol[3]);
    VRD8(lb, hb, 5); LGKW(8); PVM8(la, ha, oh[0]);
    VRD8(la, ha, 6); LGKW(8); PVM8(lb, hb, oh[1]);
    VRD8(lb, hb, 7); LGKW(8); PVM8(la, ha, oh[2]);
    LGKW(0); PVM8(lb, hb, oh[3]);
#undef TRRD
#undef LGKW
#undef VB8
#undef VRD8
#undef PVM8
}
template <int SEQ_>
__device__ __forceinline__ void vs_consumer(const BlockRefVS& cur, char* lds, int pw, int lane, int ct, int NT) {
    const int r32 = lane & 31, hi = lane >> 5;
    char* V_lds = lds; char* P_w = lds + VS_P + pw * 8192;
    const float* al_w = (const float*)(lds + VS_SMALL) + pw * 128; const float* li_w = al_w + 64; const float* fl_w = al_w + 96;
    const int sr = ct >> 4, sc = (ct & 15) * 8, vst0 = v_st(sr, sc);
    const int vb0 = (int)(uintptr_t)V_lds + v_rd_base(lane);
    const bf16_t* Vl = cur.Vlo; const bf16_t* Vh = cur.Vlo + (size_t)SEQ_ * 128;
    const unsigned rof0 = ROWB(0, sr);
    f32x16 ol[4] = {}, oh[4] = {}; bf16x8 pa0, pa1, pa2, pa3; bf16x8 st_l[4], st_h[4];
#define CLOADV(t) do { const size_t to_ = (size_t)(t) * (KVBLK * D); _Pragma("unroll") for (int i_ = 0; i_ < 4; ++i_) { st_l[i_] = load8o(Vl + to_, rof0 + i_ * (16 * D * 2)); st_h[i_] = load8o(Vh + to_, rof0 + i_ * (16 * D * 2)); } } while (0)
#define CWRITEV(bf) do { _Pragma("unroll") for (int i_ = 0; i_ < 4; ++i_) { *(bf16x8*)(V_lds + (bf) * SHM_V + vst0 + i_ * 4096) = st_l[i_]; *(bf16x8*)(V_lds + (2 + (bf)) * SHM_V + vst0 + i_ * 4096) = st_h[i_]; } } while (0)
#define CPV(PB) do { const bf16x8* pb_ = (const bf16x8*)(P_w + (PB) * 4096) + lane; pa0 = pb_[0]; pa1 = pb_[64]; pa2 = pb_[128]; pa3 = pb_[192];            \
        if (fl_w[PB] != 0.f) { for (int d_ = 0; d_ < 4; ++d_) for (int r = 0; r < 16; ++r) { const float a_ = al_w[(PB) * 32 + crow(r, hi)]; ol[d_][r] *= a_; oh[d_][r] *= a_; } } \
        asm volatile("s_waitcnt lgkmcnt(0)" ::: "memory"); SBAR(); pv8<PB>(ol, oh, vb0, pa0, pa1, pa2, pa3); SBAR(); } while (0)
#define CX(t, TP, DO_PV) do { if (DO_PV) CPV(1 - (TP)); VMW(); CWRITEV(TP);                                                                            \
        if ((t) + 1 < NT) CLOADV((t) + 1); SBAR(); VSBAR(); } while (0)
    CLOADV(0);
    VSBAR();
    VSBAR();
    CX(0, 0, false); CX(1, 1, true);
    for (int t = 2; t < NT; t += 2) { CX(t, 0, true); CX(t + 1, 1, true); }
    CPV(1);
#undef CLOADV
#undef CWRITEV
#undef CPV
#undef CX
    vs_store(ol, li_w, cur.O, pw, r32, hi, 0);
    vs_store(oh, li_w, cur.O, pw, r32, hi, 128);
}
template <int SEQ_>
__device__ __forceinline__ void attn_block_vs(const BlockRefVS& cur, char* lds, const int tid) {
    const int wid = __builtin_amdgcn_readfirstlane(tid >> 6), lane = tid & 63;
    const int NT = (cur.P0 + VS_QB - 1) / KVBLK + 1;
    if (wid < 4) vs_producer(cur, lds, wid, lane, tid, NT); else vs_consumer<SEQ_>(cur, lds, wid - 4, lane, tid - 256, NT);
    __syncthreads();
}
template <int SEQ_, class Get>
__device__ __forceinline__ void attn_stream_vs(int n, const Get& get, char* lds) {
    int tid = threadIdx.x; asm volatile("" : "+v"(tid));
    for (int i = 0; i < n; ++i) { const BlockRefVS cur = get(i); attn_block_vs<SEQ_>(cur, lds, tid); }
}
#undef ROWB
#undef VMW
#undef VMWN
#undef SLOAD_H
#undef SWRITE_HK
#undef SWRITE_HV
#undef SWRITE_H
template <int MODE, class Get>
__device__ __forceinline__ void attn_stream(int n, const Get& get, int ldo, char* lds) {
    if (n <= 0) return;
    BlockRef cur = get(0); Seam S;
    int tid = threadIdx.x; asm volatile("" : "+v"(tid));
    attn_prime<MODE>(cur, lds, S, tid);
    for (int i = 0; i < n; ++i) {
        const BlockRef nxt = (i + 1 < n) ? get(i + 1) : cur;
        attn_block<MODE>(cur, nxt, ldo, lds, S, tid);
        cur = nxt;
    }
}
}

constexpr int NWAVES = 8;
constexpr int N_PHASES = 11;
#ifndef MK_N_LAUNCHES
#define MK_N_LAUNCHES 1
#endif
constexpr int N_LAUNCHES = MK_N_LAUNCHES;
static_assert(N_LAUNCHES == 1, "the phase program needs the in-kernel grid barrier");

constexpr size_t MiB = 1u << 20;
constexpr size_t WS_CTL = 0, CTL_ZERO_BYTES = 1 * MiB;
constexpr size_t WS_ROPEC = 1 * MiB, WS_ROPES = 5 * MiB;
constexpr size_t WS_WSB = 9 * MiB, WS_WDA = 25 * MiB, WS_WOUT = 41 * MiB, WS_WP = 73 * MiB;
constexpr size_t WS_SELI = 89 * MiB, WS_SELG = 97 * MiB;
constexpr size_t WS_XB = 112 * MiB;
constexpr size_t WS_WIN = 240 * MiB;
constexpr size_t WS_GATE = 400 * MiB;
constexpr size_t WS_QKV = 656 * MiB;
constexpr size_t WS_OSB = 1040 * MiB, WS_O1 = 1104 * MiB, WS_O2 = 1168 * MiB, WS_END = 1232 * MiB;
constexpr int P_ROWB = 3072;
constexpr int P_SLICEB = 384;
constexpr size_t WS_PD = 896 * MiB, WS_ST = 960 * MiB;
constexpr size_t WS_UQ = WS_QKV, WS_VQ = WS_QKV + 64 * MiB;
constexpr size_t WS_H1Q = WS_WIN + 128 * MiB;
constexpr size_t WS_US = 105 * MiB, WS_VS = WS_US + 65536, WS_HS = WS_VS + 65536;
constexpr size_t WS_SX = WS_HS + 65536, WS_SW = WS_SX + 65536;
constexpr size_t WS_CM = 512 * 1024;
constexpr size_t WS_OSBQ = 800 * MiB, WS_ODAQ = 832 * MiB;
constexpr size_t WS_SOSB = WS_SW + 131072, WS_SODA = WS_SOSB + 65536;
constexpr size_t WS_MQ = 864 * MiB;
constexpr size_t WS_RM = 640 * 1024;
constexpr size_t WS_WPQ = WS_WDA + 8 * MiB;
constexpr size_t WS_SWP = WS_SODA + 131072;
constexpr size_t WS_LNM = WS_SODA + 196608, WS_LNR = WS_LNM + 65536;
constexpr size_t WS_SM = WS_SODA + 65536;
constexpr size_t QKV_T = (size_t)T_TOK * 2048;
constexpr int CW_BAR = 4096;

constexpr int RING_OFF = 0, RING_BYTES = 131072;
constexpr int LDSCTL_OFF = RING_BYTES, MISC_OFF = LDSCTL_OFF + 320;
constexpr int LDS_BYTES = 147456;
static_assert(MISC_OFF + 128 <= LDS_BYTES && att::LDS_BYTES <= RING_BYTES, "LDS map");

#define GAS __attribute__((address_space(1)))
#define LAS __attribute__((address_space(3)))
typedef unsigned v4u __attribute__((ext_vector_type(4)));
typedef unsigned v2u __attribute__((ext_vector_type(2)));
typedef float f32x4 __attribute__((ext_vector_type(4)));
typedef GAS unsigned gu32;
#define RLX_AGENT __ATOMIC_RELAXED, __HIP_MEMORY_SCOPE_AGENT
#define LDS_WAIT() asm volatile("s_waitcnt lgkmcnt(0)" ::: "memory")
__device__ __forceinline__ unsigned f2bf(float f) { unsigned u = __builtin_bit_cast(unsigned, f); return (u + 0x7fffu + ((u >> 16) & 1u)) >> 16; }
__device__ __forceinline__ unsigned pk2(float lo, float hi) { return f2bf(lo) | (f2bf(hi) << 16); }
__device__ __forceinline__ float bflo(unsigned w) { return __uint_as_float(w << 16); }
__device__ __forceinline__ float bfhi(unsigned w) { return __uint_as_float(w & 0xffff0000u); }
__device__ __forceinline__ float wave_sum(float v) {
#pragma unroll
    for (int o = 1; o < 64; o <<= 1) v += __shfl_xor(v, o);
    return v;
}

#define XB_TMO      128
#define XB_XCNT(j)  (256  + 64 * (j))
#define XB_XSUB(j)  (1280 + 64 * (j))
#define XB_XGEN(j)  (2304 + 64 * (j))
#define XB_TOP      3328
#define XB_TOPGEN   3392
#define XCD_BAR_WORDS 3456
#define XB_SPIN_CAP (1u << 18)

__device__ __forceinline__ unsigned xb_ld(unsigned* p)              { return __hip_atomic_load(p, __ATOMIC_RELAXED, __HIP_MEMORY_SCOPE_AGENT); }
__device__ __forceinline__ unsigned xb_add(unsigned* p, unsigned v) { return __hip_atomic_fetch_add(p, v, __ATOMIC_RELAXED, __HIP_MEMORY_SCOPE_AGENT); }
__device__ __forceinline__ unsigned xb_xcc_id() { return (unsigned)__builtin_amdgcn_s_getreg((3 << 11) | 20) & 0xFu; }
#define XB_SPIN(cond, bar) do { unsigned _sp = 0; while (cond) { __builtin_amdgcn_s_sleep(1); \
    if ((++_sp & 255u) == 0u) { if (xb_ld(&(bar)[XB_TMO])) break; if (_sp > XB_SPIN_CAP) { atomicAdd(&(bar)[XB_TMO], 1u); break; } } } } while (0)

struct XcdBarrier {
    unsigned* bar; unsigned x;
    volatile LAS unsigned* st;
};

__device__ __forceinline__ XcdBarrier xcd_barrier_post(unsigned* bar, volatile LAS unsigned* st) {
    XcdBarrier b; b.bar = bar; b.x = xb_xcc_id(); b.st = st;
    if (threadIdx.x == 0) (void)xb_add(&bar[XB_XCNT(b.x)], 1u);
    return b;
}
__device__ __forceinline__ void xcd_barrier_complete(unsigned* bar, unsigned x, unsigned& nloc, unsigned& nx) {
    const unsigned G = gridDim.x * gridDim.y * gridDim.z;
    unsigned sum, cnt, mine, sp = 0u;
    for (;;) {
        sum = 0u; cnt = 0u; mine = 0u;
#pragma unroll
        for (unsigned j = 0; j < 16; ++j) { const unsigned c = xb_ld(&bar[XB_XCNT(j)]); sum += c; cnt += (c > 0u) ? 1u : 0u; mine = (j == x) ? c : mine; }
        if (sum == G) break;
        __builtin_amdgcn_s_sleep(1);
        if ((++sp & 255u) == 0u) { if (xb_ld(&bar[XB_TMO])) break; if (sp > XB_SPIN_CAP) { atomicAdd(&bar[XB_TMO], 1u); break; } }
    }
    nloc = mine > 0u ? mine : 1u; nx = cnt > 0u ? cnt : 1u;
}

__device__ __forceinline__ void xcd_barrier(const XcdBarrier& b) {
    asm volatile("s_waitcnt vmcnt(0)" ::: "memory");
    __syncthreads();
    if (threadIdx.x == 0) {
        unsigned* bar = b.bar;
        __builtin_amdgcn_s_waitcnt(0);
        unsigned nloc = b.st[0], nx = b.st[1];
        if (nloc == 0u) { xcd_barrier_complete(bar, b.x, nloc, nx); b.st[0] = nloc; b.st[1] = nx; }
        const unsigned old = xb_add(&bar[XB_XSUB(b.x)], 1u);
        const unsigned gen = old / nloc;
        if (old + 1u == (gen + 1u) * nloc) {
            __builtin_amdgcn_fence(__ATOMIC_RELEASE, "agent");
            asm volatile("s_waitcnt vmcnt(0)" ::: "memory");
            const unsigned og = xb_add(&bar[XB_TOP], 1u);
            const unsigned tg = og / nx;
            if (og + 1u == (tg + 1u) * nx) xb_add(&bar[XB_TOPGEN], 1u);
            else XB_SPIN(xb_ld(&bar[XB_TOPGEN]) == tg, bar);
            __builtin_amdgcn_fence(__ATOMIC_ACQUIRE, "agent");
            xb_add(&bar[XB_XGEN(b.x)], 1u);
            asm volatile("s_waitcnt vmcnt(0)" ::: "memory");
        } else {
            XB_SPIN(xb_ld(&bar[XB_XGEN(b.x)]) == gen, bar);
            __builtin_amdgcn_fence(__ATOMIC_ACQUIRE, "agent");
            asm volatile("s_waitcnt vmcnt(0)" ::: "memory");
        }
    }
    __syncthreads();
}
#define NTLOAD(p) __builtin_nontemporal_load(p)
struct Frame {
    LAS unsigned char* lds; int wave, vcu, G;
    float* out; unsigned char* ws;
};
__device__ __forceinline__ int win_src_col(int n) {
    if (n < 6144 || n >= 10240) return n;
    const int j = n & 127, g = j >> 3, e = j & 7;
    return (n & ~127) + (e < 4 ? 4 * g + e : 64 + 4 * g + (e - 4));
}
template <bool REMAP>
__device__ __forceinline__ void p0_transpose_item(const float* W, int K, int N, bf16_t* WT, LAS float* scr, int item, int lane) {
    const int nblk = N / 32, kb = item / nblk, nb = item % nblk, k0 = 64 * kb, n0 = 32 * nb;
    const int srcc = REMAP ? win_src_col(n0 + (lane & 31)) : n0 + (lane & 31);
#pragma unroll 8
    for (int i = 0; i < 32; ++i) { const int kk = 2 * i + (lane >> 5); scr[kk * 33 + (lane & 31)] = W[(size_t)(k0 + kk) * N + srcc]; }
    LDS_WAIT(); asm volatile("" ::: "memory");
    const int c = lane & 7;
#pragma unroll
    for (int j = 0; j < 4; ++j) { const int n = (lane >> 3) + 8 * j; const LAS float* s = scr + (8 * c) * 33 + n;
        v4u o; o.x = pk2(s[0 * 33], s[1 * 33]); o.y = pk2(s[2 * 33], s[3 * 33]); o.z = pk2(s[4 * 33], s[5 * 33]); o.w = pk2(s[6 * 33], s[7 * 33]);
        *(GAS v4u*)(WT + (size_t)(n0 + n) * K + k0 + 8 * c) = o; }
    LDS_WAIT(); asm volatile("" ::: "memory");
}
__device__ __forceinline__ void cvt_stream(const float* src, bf16_t* dst, size_t n8, int gw, int NGW, int lane) {
    for (size_t i = (size_t)gw * 64 + lane; i < n8; i += (size_t)NGW * 64) {
        const f32x4 a = ((const GAS f32x4*)src)[2 * i], b = ((const GAS f32x4*)src)[2 * i + 1];
        v4u o; o.x = pk2(a.x, a.y); o.y = pk2(a.z, a.w); o.z = pk2(b.x, b.y); o.w = pk2(b.z, b.w);
        ((GAS v4u*)dst)[i] = o;
    }
}
template <int KC, bool NTW>
__device__ __forceinline__ void col_amax(const float* W, int K, int N, unsigned* CM, int gw, int NGW) {
    const int n4 = N / 4;
    for (int idx = gw * 64 + ((int)threadIdx.x & 63); idx < n4 * (K / KC); idx += NGW * 64) {
        const int c4 = idx % n4, kp = idx / n4;
        const GAS f32x4* src = (const GAS f32x4*)(W + (size_t)(kp * KC) * N) + c4;
        f32x4 m = (f32x4){0.f, 0.f, 0.f, 0.f};
#pragma unroll 16
        for (int k = 0; k < KC; ++k) { const f32x4 t = NTW ? NTLOAD(src + (size_t)k * n4) : src[(size_t)k * n4]; m.x = fmaxf(m.x, fabsf(t.x)); m.y = fmaxf(m.y, fabsf(t.y)); m.z = fmaxf(m.z, fabsf(t.z)); m.w = fmaxf(m.w, fabsf(t.w)); }
        atomicMax(CM + 4 * c4, __float_as_uint(m.x)); atomicMax(CM + 4 * c4 + 1, __float_as_uint(m.y)); atomicMax(CM + 4 * c4 + 2, __float_as_uint(m.z)); atomicMax(CM + 4 * c4 + 3, __float_as_uint(m.w));
    }
}
__device__ __forceinline__ void p0_prologue(Frame& F, const float* x_, const int* pos_, const float* w_in_, const float* w_sb_, const float* w_da_, const float* w_out_, const float* w_q_, const float* keys_) {
    const int gw = F.vcu * NWAVES + F.wave, NGW = F.G * NWAVES;
    bf16_t* WPt = (bf16_t*)(F.ws + WS_WP);
    {
        typedef float f32x16_ __attribute__((ext_vector_type(16)));
        const int lane = (int)threadIdx.x & 63, r = lane & 31, h = lane >> 5;
        for (int task = gw; task < 16 * 128; task += NGW) {
            const int hc = task >> 7, j0 = (task & 127) * 32;
            pg8::bf16x8 af[8];
            { const GAS f32x4* wp = (const GAS f32x4*)(w_q_ + (size_t)(j0 + r) * 2048 + hc * 128 + 8 * h);
#pragma unroll
              for (int s_ = 0; s_ < 8; ++s_) { const f32x4 a = wp[4 * s_], b = wp[4 * s_ + 1];
                  af[s_] = __builtin_bit_cast(pg8::bf16x8, (v4u){pg8::cvt_pk_bf16(a.x, a.y), pg8::cvt_pk_bf16(a.z, a.w), pg8::cvt_pk_bf16(b.x, b.y), pg8::cvt_pk_bf16(b.z, b.w)}); } }
#pragma unroll 1
            for (int kt = 0; kt < 4; ++kt) {
                const GAS f32x4* kp = (const GAS f32x4*)(keys_ + (size_t)hc * 16384 + (size_t)(32 * kt + r) * 128 + 8 * h);
                f32x16_ acc;
#pragma unroll
                for (int i = 0; i < 16; ++i) acc[i] = 0.f;
#pragma unroll
                for (int s_ = 0; s_ < 8; ++s_) { const f32x4 a = kp[4 * s_], b = kp[4 * s_ + 1];
                    const pg8::bf16x8 bfr = __builtin_bit_cast(pg8::bf16x8, (v4u){pg8::cvt_pk_bf16(a.x, a.y), pg8::cvt_pk_bf16(a.z, a.w), pg8::cvt_pk_bf16(b.x, b.y), pg8::cvt_pk_bf16(b.z, b.w)});
                    acc = __builtin_amdgcn_mfma_f32_32x32x16_bf16(af[s_], bfr, acc, 0, 0, 0); }
#pragma unroll
                for (int q = 0; q < 4; ++q) { v2u o; o.x = pk2(acc[4 * q], acc[4 * q + 1]); o.y = pk2(acc[4 * q + 2], acc[4 * q + 3]);
                    *(GAS v2u*)(WPt + (size_t)(hc * 128 + 32 * kt + r) * DM + j0 + 8 * q + 4 * h) = o; }
            }
        }
    }
    {
        const int lane = (int)threadIdx.x & 63; unsigned* XQ = (unsigned*)(F.ws + WS_XB); float* SX = (float*)(F.ws + WS_SX);
        for (int row = gw; row < T_TOK; row += NGW) {
            const GAS f32x4* src = (const GAS f32x4*)(x_ + (size_t)row * DM) + lane;
            f32x4 v[16]; float am = 0.f;
#pragma unroll
            for (int j = 0; j < 16; ++j) { v[j] = NTLOAD(src + 64 * j); am = fmaxf(am, fmaxf(fmaxf(fabsf(v[j].x), fabsf(v[j].y)), fmaxf(fabsf(v[j].z), fabsf(v[j].w)))); }
#pragma unroll
            for (int o = 1; o < 64; o <<= 1) am = fmaxf(am, __shfl_xor(am, o));
            if (am < 1e-30f) am = 1e-30f;
            const float inv = 127.f / am; if (lane == 0) SX[row] = am * (1.f / 127.f);
#pragma unroll
            for (int j = 0; j < 16; ++j) { const int a = (int)rintf(v[j].x * inv), b = (int)rintf(v[j].y * inv), c = (int)rintf(v[j].z * inv), d = (int)rintf(v[j].w * inv);
                ((GAS unsigned*)(XQ + (size_t)row * (DM / 4)))[64 * j + lane] = (unsigned)(a & 255) | ((unsigned)(b & 255) << 8) | ((unsigned)(c & 255) << 16) | ((unsigned)(d & 255) << 24); }
        }
    }
    col_amax<64, true>(w_in_, DM, IN_W, (unsigned*)(F.ws + WS_CM), gw, NGW);
    col_amax<16, false>(w_sb_, 2048, DM, (unsigned*)(F.ws + WS_CM) + IN_W, gw, NGW);
    col_amax<16, false>(w_da_, 2048, DM, (unsigned*)(F.ws + WS_CM) + IN_W + DM, gw, NGW);
    col_amax<32, false>(w_out_, DM, DM, (unsigned*)(F.ws + WS_CM) + IN_W + 2 * DM, gw, NGW);
    {
        float* rc = (float*)(F.ws + WS_ROPEC); float* rs = (float*)(F.ws + WS_ROPES);
        for (int idx = gw * 64 + ((int)threadIdx.x & 63); idx < T_TOK * 64; idx += NGW * 64) {
            const int t = idx >> 6, i = idx & 63;
            const float inv = powf(10000.0f, -((float)(2 * i) / 128.0f));
            const float ang = (float)pos_[t] * inv;
            float sn, cs; sincosf(ang, &sn, &cs);
            rc[idx] = cs; rs[idx] = sn;
        }
    }
}
template <bool REMAP>
__device__ __forceinline__ void transpose_q8(Frame& F, const float* W, int K, int N, unsigned char* WQ, const float* CMf, float* SW) {
    const int gw = F.vcu * NWAVES + F.wave, NGW = F.G * NWAVES, lane = (int)threadIdx.x & 63;
    LAS float* scr = (LAS float*)(F.lds + RING_OFF + F.wave * 16384);
    const int nblk = N / 32;
    for (int item = gw; item < (K / 64) * nblk; item += NGW) {
        const int kb = item / nblk, nb = item % nblk, k0 = 64 * kb, n0 = 32 * nb;
        const int srcc = REMAP ? win_src_col(n0 + 4 * (lane & 7)) : n0 + 4 * (lane & 7);
        f32x4 ld[8];
#pragma unroll
        for (int i = 0; i < 8; ++i) ld[i] = NTLOAD((const GAS f32x4*)(W + (size_t)(k0 + 8 * i + (lane >> 3)) * N + srcc));
#pragma unroll
        for (int i = 0; i < 8; ++i) { LAS float* d = scr + (8 * i + (lane >> 3)) * 33 + 4 * (lane & 7); d[0] = ld[i].x; d[1] = ld[i].y; d[2] = ld[i].z; d[3] = ld[i].w; }
        LDS_WAIT(); asm volatile("" ::: "memory");
        const int c = lane & 7;
#pragma unroll
        for (int j = 0; j < 4; ++j) { const int n = (lane >> 3) + 8 * j; const LAS float* sp = scr + (8 * c) * 33 + n;
            float am = CMf[REMAP ? win_src_col(n0 + n) : n0 + n]; if (am < 1e-30f) am = 1e-30f; const float inv = 127.f / am;
            if (kb == 0 && c == 0) SW[n0 + n] = am * (1.f / 127.f);
            int q[8];
#pragma unroll
            for (int e = 0; e < 8; ++e) q[e] = (int)rintf(sp[e * 33] * inv) & 255;
            v2u o; o.x = (unsigned)q[0] | ((unsigned)q[1] << 8) | ((unsigned)q[2] << 16) | ((unsigned)q[3] << 24); o.y = (unsigned)q[4] | ((unsigned)q[5] << 8) | ((unsigned)q[6] << 16) | ((unsigned)q[7] << 24);
            *(GAS v2u*)(WQ + (size_t)(n0 + n) * K + k0 + 8 * c) = o; }
        LDS_WAIT(); asm volatile("" ::: "memory");
    }
}
__device__ __forceinline__ void p0b_weights(Frame& F, const float* w_in_, const float* w_sb_, const float* w_da_, const float* w_out_) {
    const float* CMf = (const float*)(F.ws + WS_CM); float* SW = (float*)(F.ws + WS_SW);
    transpose_q8<true>(F, w_in_, DM, IN_W, F.ws + WS_WIN, CMf, SW);
    transpose_q8<false>(F, w_sb_, 2048, DM, F.ws + WS_WSB, CMf + IN_W, SW + IN_W);
    transpose_q8<false>(F, w_da_, 2048, DM, F.ws + WS_WDA, CMf + IN_W + DM, SW + IN_W + DM);
    transpose_q8<false>(F, w_out_, DM, DM, F.ws + WS_WOUT, CMf + IN_W + 2 * DM, SW + IN_W + 2 * DM);
    {
        const int gw = F.vcu * NWAVES + F.wave, NGW = F.G * NWAVES, lane = (int)threadIdx.x & 63;
        const bf16_t* WPb = (const bf16_t*)(F.ws + WS_WP); unsigned* WPQ = (unsigned*)(F.ws + WS_WPQ); float* SWP = (float*)(F.ws + WS_SWP);
        for (int row = gw; row < 2048; row += NGW) {
            v4u w[8]; float am = 0.f;
#pragma unroll
            for (int i = 0; i < 8; ++i) { w[i] = ((const GAS v4u*)(WPb + (size_t)row * DM))[64 * i + lane];
                const unsigned q_[4] = {w[i].x, w[i].y, w[i].z, w[i].w};
#pragma unroll
                for (int e = 0; e < 4; ++e) am = fmaxf(am, fmaxf(fabsf(bflo(q_[e])), fabsf(bfhi(q_[e])))); }
#pragma unroll
            for (int o = 1; o < 64; o <<= 1) am = fmaxf(am, __shfl_xor(am, o));
            if (am < 1e-30f) am = 1e-30f;
            const float inv = 127.f / am; if (lane == 0) SWP[row] = am * (1.f / 127.f);
#pragma unroll
            for (int i = 0; i < 8; ++i) { const unsigned q_[4] = {w[i].x, w[i].y, w[i].z, w[i].w}; v2u o;
#pragma unroll
                for (int h = 0; h < 2; ++h) { const int a = (int)rintf(bflo(q_[2 * h]) * inv) & 255, b = (int)rintf(bfhi(q_[2 * h]) * inv) & 255, c = (int)rintf(bflo(q_[2 * h + 1]) * inv) & 255, d = (int)rintf(bfhi(q_[2 * h + 1]) * inv) & 255;
                    const unsigned pk = (unsigned)a | ((unsigned)b << 8) | ((unsigned)c << 16) | ((unsigned)d << 24); if (h == 0) o.x = pk; else o.y = pk; }
                ((GAS v2u*)(WPQ + (size_t)row * (DM / 4)))[64 * i + lane] = o; }
        }
    }
}
__device__ __forceinline__ void p3_combine(Frame& F, const float* lq1, const float* lk1, const float* lq2, const float* lk2, const float* subln_g, const float* pu_, const float* pv_) {
    const int gw = F.vcu * NWAVES + F.wave, NGW = F.G * NWAVES, lane = ((int)threadIdx.x & 63);
    float d1 = lq1[lane] * lk1[lane] + lq1[lane + 64] * lk1[lane + 64];
    float d2 = lq2[lane] * lk2[lane] + lq2[lane + 64] * lk2[lane + 64];
    d1 = wave_sum(d1); d2 = wave_sum(d2);
    const float lam = expf(d1) - expf(d2) + LAM_INIT;
    const f32x4 g4 = *(const f32x4*)(subln_g + 4 * lane);
    const bf16_t* O1 = (const bf16_t*)(F.ws + WS_O1); const bf16_t* O2 = (const bf16_t*)(F.ws + WS_O2);
    unsigned* OSBQ = (unsigned*)(F.ws + WS_OSBQ); unsigned* ODAQ = (unsigned*)(F.ws + WS_ODAQ); float* SOSB = (float*)(F.ws + WS_SOSB); float* SODA = (float*)(F.ws + WS_SODA);
    const bf16_t* OSB = (const bf16_t*)(F.ws + WS_OSB);
    for (int tok = gw; tok < T_TOK; tok += NGW) {
        float od[DA_HEADS][4]; float am = 0.f;
#pragma unroll
        for (int h = 0; h < DA_HEADS; ++h) {
            const size_t off = (size_t)tok * 2048 + h * 256 + 4 * lane;
            const v2u a = NTLOAD((const GAS v2u*)(O1 + off)), b = NTLOAD((const GAS v2u*)(O2 + off));
            const float v0 = bflo(a.x) - lam * bflo(b.x), v1 = bfhi(a.x) - lam * bfhi(b.x), v2 = bflo(a.y) - lam * bflo(b.y), v3 = bfhi(a.y) - lam * bfhi(b.y);
            const float ss = wave_sum((v0 * v0 + v1 * v1) + (v2 * v2 + v3 * v3));
            const float r = (1.0f - LAM_INIT) / sqrtf(ss * (1.0f / 256.0f) + LN_EPS);
            od[h][0] = v0 * r * g4.x; od[h][1] = v1 * r * g4.y; od[h][2] = v2 * r * g4.z; od[h][3] = v3 * r * g4.w;
            am = fmaxf(am, fmaxf(fmaxf(fabsf(od[h][0]), fabsf(od[h][1])), fmaxf(fabsf(od[h][2]), fabsf(od[h][3]))));
        }
#pragma unroll
        for (int o = 1; o < 64; o <<= 1) am = fmaxf(am, __shfl_xor(am, o));
        if (am < 1e-30f) am = 1e-30f;
        { const float inv = 127.f / am; if (lane == 0) SODA[tok] = am * (1.f / 127.f);
#pragma unroll
          for (int h = 0; h < DA_HEADS; ++h) { const int a = (int)rintf(od[h][0] * inv), b = (int)rintf(od[h][1] * inv), c = (int)rintf(od[h][2] * inv), d = (int)rintf(od[h][3] * inv);
              ((GAS unsigned*)(ODAQ + (size_t)tok * 512))[64 * h + lane] = (unsigned)(a & 255) | ((unsigned)(b & 255) << 8) | ((unsigned)(c & 255) << 16) | ((unsigned)(d & 255) << 24); } }
        v2u sb[8]; float am2 = 0.f;
#pragma unroll
        for (int i = 0; i < 8; ++i) { sb[i] = NTLOAD((const GAS v2u*)(OSB + (size_t)tok * 2048) + 64 * i + lane);
            am2 = fmaxf(am2, fmaxf(fmaxf(fabsf(bflo(sb[i].x)), fabsf(bfhi(sb[i].x))), fmaxf(fabsf(bflo(sb[i].y)), fabsf(bfhi(sb[i].y))))); }
#pragma unroll
        for (int o = 1; o < 64; o <<= 1) am2 = fmaxf(am2, __shfl_xor(am2, o));
        if (am2 < 1e-30f) am2 = 1e-30f;
        { const float inv = 127.f / am2; if (lane == 0) SOSB[tok] = am2 * (1.f / 127.f);
#pragma unroll
          for (int i = 0; i < 8; ++i) { const int a = (int)rintf(bflo(sb[i].x) * inv), b = (int)rintf(bfhi(sb[i].x) * inv), c = (int)rintf(bflo(sb[i].y) * inv), d = (int)rintf(bfhi(sb[i].y) * inv);
              ((GAS unsigned*)(OSBQ + (size_t)tok * 512))[64 * i + lane] = (unsigned)(a & 255) | ((unsigned)(b & 255) << 8) | ((unsigned)(c & 255) << 16) | ((unsigned)(d & 255) << 24); } }
    }
    {
        typedef float v16f_ __attribute__((ext_vector_type(16))); typedef int v6i_ __attribute__((ext_vector_type(6)));
        float* US = (float*)(F.ws + WS_US); float* VS = (float*)(F.ws + WS_VS);
        for (int r = gw; r < 2 * P_EXP; r += NGW) {
            const bool isv = r >= P_EXP; const int e = isv ? r - P_EXP : r;
            const GAS f32x4* src = (const GAS f32x4*)((isv ? pv_ : pu_) + (size_t)e * DM) + lane;
            f32x4 v[16]; float am = 0.f;
#pragma unroll
            for (int j = 0; j < 16; ++j) { v[j] = NTLOAD(src + 64 * j); am = fmaxf(am, fmaxf(fmaxf(fabsf(v[j].x), fabsf(v[j].y)), fmaxf(fabsf(v[j].z), fabsf(v[j].w)))); }
#pragma unroll
            for (int o = 1; o < 64; o <<= 1) am = fmaxf(am, __shfl_xor(am, o));
            if (am < 1e-30f) am = 1e-30f;
            const float inv = 7.5f / am; if (lane == 0) (isv ? VS : US)[e] = am * (1.f / 7.5f);
            v16f_ x0, y0, x1, y1;
#pragma unroll
            for (int i = 0; i < 16; ++i) { x0[i] = v[i >> 1][2 * (i & 1)] * inv; y0[i] = v[i >> 1][2 * (i & 1) + 1] * inv; x1[i] = v[8 + (i >> 1)][2 * (i & 1)] * inv; y1[i] = v[8 + (i >> 1)][2 * (i & 1) + 1] * inv; }
            const v6i_ p0 = __builtin_amdgcn_cvt_scalef32_2xpk16_fp6_f32(x0, y0, 1.0f), p1 = __builtin_amdgcn_cvt_scalef32_2xpk16_fp6_f32(x1, y1, 1.0f);
            GAS unsigned char* dst = (GAS unsigned char*)(F.ws + (isv ? WS_VQ : WS_UQ) + ((size_t)(lane >> 3) * P_EXP + e) * P_SLICEB);
            ((GAS v4u*)dst)[2 * (lane & 7)] = (v4u){(unsigned)p0[0], (unsigned)p0[1], (unsigned)p0[2], (unsigned)p0[3]};
            ((GAS v4u*)dst)[2 * (lane & 7) + 1] = (v4u){(unsigned)p1[0], (unsigned)p1[1], (unsigned)p1[2], (unsigned)p1[3]};
            ((GAS v4u*)(dst + 256))[lane & 7] = (v4u){(unsigned)p0[4], (unsigned)p0[5], (unsigned)p1[4], (unsigned)p1[5]};
        }
    }
}
__device__ __forceinline__ void p5b_quant(Frame& F) {
    const int gw = F.vcu * NWAVES + F.wave, NGW = F.G * NWAVES, lane = ((int)threadIdx.x & 63);
    const bf16_t* MB = (const bf16_t*)(F.ws + WS_XB); unsigned* MQ = (unsigned*)(F.ws + WS_MQ); const float* RM = (const float*)(F.ws + WS_RM); float* SM = (float*)(F.ws + WS_SM);
    for (int row = gw; row < T_TOK; row += NGW) {
        float am = RM[row]; if (am < 1e-30f) am = 1e-30f;
        const float inv = 127.f / am; if (lane == 0) SM[row] = am * (1.f / 127.f);
#pragma unroll
        for (int i = 0; i < 8; ++i) { const v4u w = NTLOAD((const GAS v4u*)(MB + (size_t)row * DM) + 64 * i + lane);
            const unsigned ws_[4] = {w.x, w.y, w.z, w.w}; v2u o;
#pragma unroll
            for (int h = 0; h < 2; ++h) { int q[4];
#pragma unroll
                for (int e = 0; e < 2; ++e) { const int a = (int)rintf(bflo(ws_[2 * h + e]) * inv), b = (int)rintf(bfhi(ws_[2 * h + e]) * inv);
                    q[2 * e] = (a < -127 ? -127 : (a > 127 ? 127 : a)) & 255; q[2 * e + 1] = (b < -127 ? -127 : (b > 127 ? 127 : b)) & 255; }
                const unsigned pk = (unsigned)q[0] | ((unsigned)q[1] << 8) | ((unsigned)q[2] << 16) | ((unsigned)q[3] << 24); if (h == 0) o.x = pk; else o.y = pk; }
            ((GAS v2u*)(MQ + (size_t)row * (DM / 4)))[64 * i + lane] = o; }
    }
}
__device__ __forceinline__ void p7_ln1(Frame& F, const float* ln1_g, const float* ln1_b) {
    const int gw = F.vcu * NWAVES + F.wave, NGW = F.G * NWAVES, lane = ((int)threadIdx.x & 63);
    unsigned* H1Q = (unsigned*)(F.ws + WS_H1Q); float* HS = (float*)(F.ws + WS_HS); float* LNM = (float*)(F.ws + WS_LNM); float* LNR = (float*)(F.ws + WS_LNR);
    for (int row = gw; row < T_TOK; row += NGW) {
        const GAS f32x4* yr = (GAS f32x4*)(F.out + (size_t)row * DM) + lane;
        f32x4 v[16]; float s = 0.f;
#pragma unroll
        for (int j = 0; j < 16; ++j) { v[j] = NTLOAD(yr + 64 * j); s += (v[j].x + v[j].y) + (v[j].z + v[j].w); }
        const float mean = wave_sum(s) * (1.f / DM); float s2 = 0.f;
#pragma unroll
        for (int j = 0; j < 16; ++j) { v[j] = v[j] - mean; s2 += (v[j].x * v[j].x + v[j].y * v[j].y) + (v[j].z * v[j].z + v[j].w * v[j].w); }
        const float rstd = 1.f / sqrtf(wave_sum(s2) * (1.f / DM) + LN_EPS);
        if (lane == 0) { LNM[row] = mean; LNR[row] = rstd; }
        float am = 0.f;
        const float* g1p = ln1_g; const float* b1p = ln1_b; asm volatile("" : "+s"(g1p), "+s"(b1p));
#pragma unroll
        for (int j = 0; j < 16; ++j) {
            const f32x4 g = ((const f32x4*)g1p)[64 * j + lane], b = ((const f32x4*)b1p)[64 * j + lane];
            const f32x4 o = v[j] * rstd * g + b;
            v[j] = o;
            am = fmaxf(am, fmaxf(fmaxf(fabsf(o.x), fabsf(o.y)), fmaxf(fabsf(o.z), fabsf(o.w))));
        }
#pragma unroll
        for (int o = 1; o < 64; o <<= 1) am = fmaxf(am, __shfl_xor(am, o));
        if (am < 1e-30f) am = 1e-30f;
        const float inv = 127.f / am; if (lane == 0) HS[row] = am * (1.f / 127.f);
#pragma unroll
        for (int j = 0; j < 16; ++j) { const int a = (int)rintf(v[j].x * inv), b = (int)rintf(v[j].y * inv), c = (int)rintf(v[j].z * inv), d = (int)rintf(v[j].w * inv);
            ((GAS unsigned*)(H1Q + (size_t)row * (DM / 4)))[64 * j + lane] = (unsigned)(a & 255) | ((unsigned)(b & 255) << 8) | ((unsigned)(c & 255) << 16) | ((unsigned)(d & 255) << 24); }
    }
}
__device__ __forceinline__ int med3i(int a, int b, int c) { int r; asm("v_med3_i32 %0, %1, %2, %3" : "=v"(r) : "v"(a), "v"(b), "v"(c)); return r; }
__device__ __forceinline__ int skey(float x) { const int b = __float_as_int(x); return b >= 0 ? b : (b ^ 0x7fffffff); }
#define INS16(T, key) do { const int k__ = (key); _Pragma("unroll") for (int i_ = 15; i_ >= 1; --i_) T[i_] = med3i(T[i_ - 1], T[i_], k__); T[0] = T[0] > k__ ? T[0] : k__; } while (0)
__device__ __forceinline__ void p9_topk(Frame& F) {
    const int gw = F.vcu * NWAVES + F.wave, NGW = F.G * NWAVES, lane = ((int)threadIdx.x & 63);
    const float* SC = (const float*)(F.ws + WS_XB); int* SELI = (int*)(F.ws + WS_SELI); float* SELG = (float*)(F.ws + WS_SELG);
    LAS float* buf = (LAS float*)(F.lds + RING_OFF + F.wave * 9216);
    for (int task = gw; task < T_TOK / 4; task += NGW) {
        const float* blk = SC + (size_t)task * 4 * 2048;
        int t[16];
#pragma unroll
        for (int i = 0; i < 16; ++i) t[i] = (int)0x80000000;
        for (int c = 0; c < 4; ++c) {
            f32x4 st[8];
#pragma unroll
            for (int i = 0; i < 8; ++i) st[i] = *(const GAS f32x4*)(blk + (size_t)((lane >> 3) + 8 * i) * 128 + c * 32 + (lane & 7) * 4);
            LDS_WAIT();
#pragma unroll
            for (int i = 0; i < 8; ++i) *(LAS f32x4*)(buf + ((lane >> 3) + 8 * i) * 36 + (lane & 7) * 4) = st[i];
            LDS_WAIT();
#pragma unroll
            for (int k8 = 0; k8 < 8; ++k8) { const f32x4 x = *(const LAS f32x4*)(buf + lane * 36 + k8 * 4);
#pragma unroll
                for (int e = 0; e < 4; ++e) { const int k = c * 32 + k8 * 4 + e; INS16(t, (skey(x[e]) & ~127) | (127 - k)); } }
        }
        const int tok = task * 4 + (lane >> 4), hc = lane & 15;
        const float* myrow = SC + (size_t)tok * 2048 + hc * 128;
        float va[16], vb[16]; int ia[16], ib[16];
#pragma unroll
        for (int i = 0; i < 16; ++i) { ia[i] = 127 - (t[i] & 127); va[i] = myrow[ia[i]]; }
#pragma unroll
        for (int i = 0; i < 16; ++i) { vb[i] = __shfl_down(va[i], 1); ib[i] = __shfl_down(ia[i], 1); }
        LDS_WAIT();
        if ((lane & 1) == 0) {
            int r[16];
#pragma unroll
            for (int i = 0; i < 16; ++i) r[i] = (int)0x80000000;
#pragma unroll
            for (int a = 0; a < 16; ++a)
#pragma unroll
                for (int b = 0; b < 16; ++b) if ((a + 1) * (b + 1) <= 16) INS16(r, (skey(va[a] + vb[b]) & ~255) | (255 - (a * 16 + b)));
            LAS float* my = buf + (lane >> 1) * 65; LAS int* myi = (LAS int*)my;
#pragma unroll
            for (int i = 0; i < 16; ++i) { my[i] = va[i]; my[16 + i] = vb[i]; myi[32 + i] = ia[i]; myi[48 + i] = ib[i]; }
            LDS_WAIT();
            float best[16]; int ex[16]; float m = -3.0e38f;
#pragma unroll
            for (int i = 0; i < 16; ++i) { const int pos = 255 - (r[i] & 255), a = pos >> 4, b = pos & 15; best[i] = my[a] + my[16 + b]; ex[i] = myi[32 + a] * P_KEYS + myi[48 + b]; m = fmaxf(m, best[i]); }
            float den = 0.f;
#pragma unroll
            for (int i = 0; i < 16; ++i) { best[i] = expf(best[i] - m); den += best[i]; }
            const float rden = 1.f / den;
            GAS v4u* oi = (GAS v4u*)(SELI + (size_t)tok * P_SEL + (hc >> 1) * 16); GAS f32x4* og = (GAS f32x4*)(SELG + (size_t)tok * P_SEL + (hc >> 1) * 16);
#pragma unroll
            for (int i = 0; i < 4; ++i) { oi[i] = (v4u){(unsigned)ex[4 * i], (unsigned)ex[4 * i + 1], (unsigned)ex[4 * i + 2], (unsigned)ex[4 * i + 3]};
                og[i] = (f32x4){best[4 * i] * rden, best[4 * i + 1] * rden, best[4 * i + 2] * rden, best[4 * i + 3] * rden}; }
        }
        LDS_WAIT();
    }
}
typedef float v32f_t __attribute__((ext_vector_type(32)));
typedef __bf16 v32bf_t __attribute__((ext_vector_type(32)));
typedef __bf16 bf2_t __attribute__((ext_vector_type(2)));
typedef __bf16 bf4_t __attribute__((ext_vector_type(4)));
typedef float f32x2_t __attribute__((ext_vector_type(2)));
typedef int v6i_t __attribute__((ext_vector_type(6)));

__device__ __forceinline__ float row16_sum(float v) {
    v += __builtin_bit_cast(float, __builtin_amdgcn_update_dpp(0, __builtin_bit_cast(int, v), 0xB1, 0xF, 0xF, true));
    v += __builtin_bit_cast(float, __builtin_amdgcn_update_dpp(0, __builtin_bit_cast(int, v), 0x4E, 0xF, 0xF, true));
    v += __builtin_bit_cast(float, __builtin_amdgcn_update_dpp(0, __builtin_bit_cast(int, v), 0x141, 0xF, 0xF, true));
    v += __builtin_bit_cast(float, __builtin_amdgcn_update_dpp(0, __builtin_bit_cast(int, v), 0x140, 0xF, 0xF, true));
    return v;
}
#define P10S_LOAD8(RA, RB, TAB, I0) do { const v4u ia_ = *(const LAS v4u*)(idb + s * 128 + (I0)), ib_ = *(const LAS v4u*)(idb + s * 128 + (I0) + 4); \
        const unsigned ie_[8] = {ia_.x, ia_.y, ia_.z, ia_.w, ib_.x, ib_.y, ib_.z, ib_.w}; \
        _Pragma("unroll") for (int j_ = 0; j_ < 8; ++j_) { const GAS unsigned char* p_ = (TAB) + (size_t)ie_[j_] * P_SLICEB; RA[j_] = *(const GAS v4u*)p_; RB[j_] = *(const GAS v2u*)(p_ + 256 - 8 * g); } \
        __builtin_amdgcn_sched_barrier(0); } while (0)
__device__ __forceinline__ void p10a_dots(Frame& F, const float* ln1_g, const float* ln1_b) {
    int tid_ = (int)threadIdx.x; asm volatile("" : "+v"(tid_));
    const int lane = tid_ & 63, s = lane >> 4, g = lane & 15, lp = g >> 1, k = g & 1;
    const int x = (int)blockIdx.x & 7, wgi = ((int)blockIdx.x >> 3) * NWAVES + F.wave, NWX = ((F.G - x + 7) >> 3) * NWAVES;
    LAS int* idb = (LAS int*)(F.lds + RING_OFF + F.wave * 4096); LAS float* zb = (LAS float*)(idb + 512);
    const int* SELI = (const int*)(F.ws + WS_SELI); float* PD = (float*)(F.ws + WS_PD) + (size_t)x * T_TOK * P_SEL;
    const GAS unsigned char* UQx = (const GAS unsigned char*)(F.ws + WS_UQ + (size_t)x * P_EXP * P_SLICEB + 16 * g);
#pragma unroll 1
    for (int t4 = wgi; t4 < T_TOK / 4; t4 += NWX) {
        const int t0 = 4 * t4;
        { const GAS v4u* sp = (const GAS v4u*)(SELI + (size_t)t0 * P_SEL); const v4u a = sp[lane], b = sp[64 + lane]; ((LAS v4u*)idb)[lane] = a; ((LAS v4u*)idb)[64 + lane] = b; }
        v2u hb[8];
        { const GAS f32x4* hp = (const GAS f32x4*)(F.out + (size_t)(t0 + s) * DM + 32 * x + 4 * lp) + 64 * 8 * k;
          const f32x4* g1 = (const f32x4*)ln1_g + 64 * 8 * k + 8 * x + lp; const f32x4* b1 = (const f32x4*)ln1_b + 64 * 8 * k + 8 * x + lp;
          asm volatile("" : "+v"(g1), "+v"(b1));
          const float m1 = ((const float*)(F.ws + WS_LNM))[t0 + s], r1 = ((const float*)(F.ws + WS_LNR))[t0 + s];
#pragma unroll
          for (int jj = 0; jj < 8; ++jj) { const f32x4 h = (hp[64 * jj] - m1) * r1 * g1[64 * jj] + b1[64 * jj]; hb[jj].x = pg8::cvt_pk_bf16(h.x, h.y); hb[jj].y = pg8::cvt_pk_bf16(h.z, h.w); } }
        LDS_WAIT();
#define P10_D2(dst, i) dst = __builtin_amdgcn_fdot2_f32_bf16(__builtin_shufflevector(__builtin_bit_cast(bf4_t, hb[(i) >> 1]), __builtin_bit_cast(bf4_t, hb[(i) >> 1]), 2 * ((i) & 1), 2 * ((i) & 1) + 1), \
                                                         __builtin_shufflevector(rb_, rb_, 2 * (i), 2 * (i) + 1), dst, false)
#define P10S_DOT8(RA, RB, I0) do { float d_[8]; _Pragma("unroll") for (int j_ = 0; j_ < 8; ++j_) { asm volatile("" : "+v"(RA[j_]), "+v"(RB[j_])); \
            const v32bf_t rb_ = __builtin_amdgcn_cvt_scalef32_pk32_bf16_fp6((v6i_t){(int)RA[j_].x, (int)RA[j_].y, (int)RA[j_].z, (int)RA[j_].w, (int)RB[j_].x, (int)RB[j_].y}, 1.0f); float dd_ = 0.f; \
            P10_D2(dd_, 0); P10_D2(dd_, 1); P10_D2(dd_, 2); P10_D2(dd_, 3); P10_D2(dd_, 4); P10_D2(dd_, 5); P10_D2(dd_, 6); P10_D2(dd_, 7); \
            P10_D2(dd_, 8); P10_D2(dd_, 9); P10_D2(dd_, 10); P10_D2(dd_, 11); P10_D2(dd_, 12); P10_D2(dd_, 13); P10_D2(dd_, 14); P10_D2(dd_, 15); \
            asm volatile("" : "+v"(dd_)); d_[j_] = dd_; __builtin_amdgcn_sched_barrier(0); } \
        _Pragma("unroll") for (int j_ = 0; j_ < 8; ++j_) d_[j_] = row16_sum(d_[j_]); \
        if (g == 0) { *(LAS f32x4*)(zb + s * 128 + (I0)) = (f32x4){d_[0], d_[1], d_[2], d_[3]}; *(LAS f32x4*)(zb + s * 128 + (I0) + 4) = (f32x4){d_[4], d_[5], d_[6], d_[7]}; } \
        __builtin_amdgcn_sched_barrier(0); } while (0)
        v4u raA[8], rbA[8]; v2u raB[8], rbB[8];
        P10S_LOAD8(raA, raB, UQx, 0);
#pragma unroll 1
        for (int i0 = 0; i0 < 112; i0 += 16) { P10S_LOAD8(rbA, rbB, UQx, i0 + 8); P10S_DOT8(raA, raB, i0); P10S_LOAD8(raA, raB, UQx, i0 + 16); P10S_DOT8(rbA, rbB, i0 + 8); }
        P10S_LOAD8(rbA, rbB, UQx, 120); P10S_DOT8(raA, raB, 112); P10S_DOT8(rbA, rbB, 120);
#undef P10S_DOT8
#undef P10_D2
        LDS_WAIT();
        { GAS f32x4* pd = (GAS f32x4*)(PD + (size_t)t0 * P_SEL); pd[lane] = ((const LAS f32x4*)zb)[lane]; pd[64 + lane] = ((const LAS f32x4*)zb)[64 + lane]; }
        LDS_WAIT();
    }
}
__device__ __forceinline__ void p10b_axpy(Frame& F, const float* ln1_g, const float* ln1_b) {
    int tid_ = (int)threadIdx.x; asm volatile("" : "+v"(tid_));
    const int lane = tid_ & 63, s = lane >> 4, g = lane & 15, lp = g >> 1, k = g & 1;
    const int x = (int)blockIdx.x & 7, wgi = ((int)blockIdx.x >> 3) * NWAVES + F.wave, NWX = ((F.G - x + 7) >> 3) * NWAVES;
    LAS int* idb = (LAS int*)(F.lds + RING_OFF + F.wave * 4096); LAS float* wb = (LAS float*)(idb + 512);
    const int* SELI = (const int*)(F.ws + WS_SELI); const float* SELG = (const float*)(F.ws + WS_SELG); const float* PD = (const float*)(F.ws + WS_PD); float* ST = (float*)(F.ws + WS_ST);
    const float* US = (const float*)(F.ws + WS_US); const float* VS = (const float*)(F.ws + WS_VS);
    const GAS unsigned char* VQx = (const GAS unsigned char*)(F.ws + WS_VQ + (size_t)x * P_EXP * P_SLICEB + 16 * g);
#pragma unroll 1
    for (int t4 = wgi; t4 < T_TOK / 4; t4 += NWX) {
        const int t0 = 4 * t4;
#pragma unroll
        for (int hf = 0; hf < 2; ++hf) {
            const size_t eo = (size_t)t0 * P_SEL + 256 * hf + 4 * lane;
            const v4u id = *(const GAS v4u*)(SELI + eo); const f32x4 gt = *(const GAS f32x4*)(SELG + eo);
            f32x4 z = *(const GAS f32x4*)(PD + eo);
#pragma unroll
            for (int xx = 1; xx < 8; ++xx) z += *(const GAS f32x4*)(PD + (size_t)xx * T_TOK * P_SEL + eo);
            const f32x4 us = (f32x4){US[id.x], US[id.y], US[id.z], US[id.w]}, vs = (f32x4){VS[id.x], VS[id.y], VS[id.z], VS[id.w]};
            const pg8::f32x2 g0 = pg8::gelu_pk((pg8::f32x2){z.x * us.x, z.y * us.y}), g1 = pg8::gelu_pk((pg8::f32x2){z.z * us.z, z.w * us.w});
            ((LAS v4u*)idb)[64 * hf + lane] = id;
            ((LAS f32x4*)wb)[64 * hf + lane] = (f32x4){gt.x * g0.x * vs.x, gt.y * g0.y * vs.y, gt.z * g1.x * vs.z, gt.w * g1.y * vs.w};
        }
        LDS_WAIT();
        f32x4 acc[8];
#pragma unroll
        for (int j = 0; j < 8; ++j) acc[j] = (f32x4){0.f, 0.f, 0.f, 0.f};
#define P10S_AXPY8(RA, RB, I0) do { const f32x4 wa_ = *(const LAS f32x4*)(wb + s * 128 + (I0)), wb_ = *(const LAS f32x4*)(wb + s * 128 + (I0) + 4); \
        const float we_[8] = {wa_.x, wa_.y, wa_.z, wa_.w, wb_.x, wb_.y, wb_.z, wb_.w}; \
        _Pragma("unroll") for (int j_ = 0; j_ < 8; ++j_) { asm volatile("" : "+v"(RA[j_]), "+v"(RB[j_])); \
            const v32f_t r_ = __builtin_amdgcn_cvt_scalef32_pk32_f32_fp6((v6i_t){(int)RA[j_].x, (int)RA[j_].y, (int)RA[j_].z, (int)RA[j_].w, (int)RB[j_].x, (int)RB[j_].y}, 1.0f); const float w_ = we_[j_]; \
            _Pragma("unroll") for (int q_ = 0; q_ < 8; ++q_) { acc[q_].x = fmaf(w_, r_[4 * q_], acc[q_].x); acc[q_].y = fmaf(w_, r_[4 * q_ + 1], acc[q_].y); acc[q_].z = fmaf(w_, r_[4 * q_ + 2], acc[q_].z); acc[q_].w = fmaf(w_, r_[4 * q_ + 3], acc[q_].w); } \
            asm volatile("" : "+v"(acc[0]), "+v"(acc[1]), "+v"(acc[2]), "+v"(acc[3]), "+v"(acc[4]), "+v"(acc[5]), "+v"(acc[6]), "+v"(acc[7])); __builtin_amdgcn_sched_barrier(0); } } while (0)
        v4u raA[8], rbA[8]; v2u raB[8], rbB[8];
        P10S_LOAD8(raA, raB, VQx, 0);
#pragma unroll 1
        for (int i0 = 0; i0 < 112; i0 += 16) { P10S_LOAD8(rbA, rbB, VQx, i0 + 8); P10S_AXPY8(raA, raB, i0); P10S_LOAD8(raA, raB, VQx, i0 + 16); P10S_AXPY8(rbA, rbB, i0 + 8); }
        P10S_LOAD8(rbA, rbB, VQx, 120); P10S_AXPY8(raA, raB, 112); P10S_AXPY8(rbA, rbB, 120);
#undef P10S_AXPY8
        { GAS f32x4* hp = (GAS f32x4*)(F.out + (size_t)(t0 + s) * DM + 32 * x + 4 * lp) + 64 * 8 * k; float sm = 0.f;
          const f32x4* g1 = (const f32x4*)ln1_g + 64 * 8 * k + 8 * x + lp; const f32x4* b1 = (const f32x4*)ln1_b + 64 * 8 * k + 8 * x + lp;
          asm volatile("" : "+v"(g1), "+v"(b1));
          const float m1 = ((const float*)(F.ws + WS_LNM))[t0 + s], r1 = ((const float*)(F.ws + WS_LNR))[t0 + s];
#pragma unroll
          for (int jj = 0; jj < 8; ++jj) { acc[jj] = ((hp[64 * jj] - m1) * r1 * g1[64 * jj] + b1[64 * jj]) * DN_ALPHA + acc[jj]; sm += (acc[jj].x + acc[jj].y) + (acc[jj].z + acc[jj].w); }
          sm = row16_sum(sm); const float mu = sm * (1.f / 512.f); float m2 = 0.f;
#pragma unroll
          for (int jj = 0; jj < 8; ++jj) { hp[64 * jj] = acc[jj]; const f32x4 dv = acc[jj] - mu; m2 += (dv.x * dv.x + dv.y * dv.y) + (dv.z * dv.z + dv.w * dv.w); }
          m2 = row16_sum(m2);
          if (g == 0) { GAS f32x2_t* st = (GAS f32x2_t*)(ST + ((size_t)x * T_TOK + t0 + s) * 2); *st = (f32x2_t){sm, m2}; } }
        LDS_WAIT();
    }
}
#undef P10S_LOAD8
__device__ __forceinline__ void p10c_ln2(Frame& F, const float* ln2_g, const float* ln2_b) {
    const int gw = F.vcu * NWAVES + F.wave, NGW = F.G * NWAVES, lane = ((int)threadIdx.x & 63);
    const float* ST = (const float*)(F.ws + WS_ST);
    for (int row = gw; row < T_TOK; row += NGW) {
        GAS f32x4* yr = (GAS f32x4*)(F.out + (size_t)row * DM) + lane;
        f32x4 v[16];
#pragma unroll
        for (int j = 0; j < 16; ++j) v[j] = NTLOAD(yr + 64 * j);
        const f32x2_t st = *(const GAS f32x2_t*)(ST + ((size_t)(lane & 7) * T_TOK + row) * 2);
        float sm = st.x; sm += __shfl_xor(sm, 1); sm += __shfl_xor(sm, 2); sm += __shfl_xor(sm, 4);
        const float mean = sm * (1.f / DM);
        const float dm = st.x * (1.f / 512.f) - mean; float m2 = st.y + 512.f * dm * dm; m2 += __shfl_xor(m2, 1); m2 += __shfl_xor(m2, 2); m2 += __shfl_xor(m2, 4);
        const float rstd = 1.f / sqrtf(m2 * (1.f / DM) + LN_EPS);
#pragma unroll
        for (int j = 0; j < 16; ++j) { const f32x4 g = ((const f32x4*)ln2_g)[64 * j + lane], b = ((const f32x4*)ln2_b)[64 * j + lane];
            __builtin_nontemporal_store((v[j] - mean) * rstd * g + b, yr + 64 * j); }
    }
}
struct DaGetVS {
    unsigned char* ws; int g, G;
    __device__ __forceinline__ att::BlockRefVS operator()(int i) const {
        const bf16_t* Qb = (const bf16_t*)(ws + WS_QKV) + 3 * QKV_T; const bf16_t* Kb = Qb + QKV_T; const bf16_t* Vb = Kb + QKV_T; bf16_t* O1 = (bf16_t*)(ws + WS_O1); bf16_t* O2 = (bf16_t*)(ws + WS_O2);
        const int L = g + (i >> 1) * G, second = i & 1;
        const int xcd = L & 7, j = (L >> 3) & 31, rr = L >> 8;
        const int y = j & 15, qk = j >> 4, bh = rr * 8 + xcd, b = bh >> 3, h = bh & 7;
        const int qb = second ? 31 - y : y, hq = 2 * h + qk;
        att::BlockRefVS r;
        r.Q = Qb + ((size_t)(b * 16 + hq) * SEQ + (size_t)qb * 128) * 128; r.K = Kb + (size_t)(b * 16 + hq) * SEQ * 128; r.Vlo = Vb + (size_t)(b * 16 + 2 * h) * SEQ * 128;
        r.O = (qk ? O2 : O1) + ((size_t)b * SEQ + (size_t)qb * 128) * 2048 + h * 256; r.P0 = qb * 128;
        return r;
    }
};
struct SbGet {
    unsigned char* ws; int g, G;
    __device__ __forceinline__ att::BlockRef operator()(int i) const {
        const bf16_t* Qb = (const bf16_t*)(ws + WS_QKV); const bf16_t* Kb = Qb + QKV_T; const bf16_t* Vb = Kb + QKV_T; bf16_t* O = (bf16_t*)(ws + WS_OSB);
        const int L = g + i * G, bh = L >> 4, qb = L & 15, b = bh >> 4, h = bh & 15;
        att::BlockRef r;
        r.Q = Qb + ((size_t)bh * SEQ + (size_t)qb * 256) * 128; r.K = Kb + (size_t)bh * SEQ * 128; r.V = Vb + (size_t)bh * SEQ * 128;
        r.O = O + ((size_t)b * SEQ + (size_t)qb * 256) * 2048 + h * 128; r.P0 = qb * 256;
        return r;
    }
};

struct Args;
#define KARGS() ({ const __attribute__((address_space(4))) Args* p_ = (const __attribute__((address_space(4))) Args*)__builtin_amdgcn_kernarg_segment_ptr(); asm volatile("" : "+s"(p_)); p_; })
struct Args { const void* in[20]; float* out; unsigned char* ws; int ph_lo, ph_hi, li, pad; };
__global__ void __launch_bounds__(NWAVES * 64, 2) fwd(Args args) {
    extern __shared__ __attribute__((aligned(16))) unsigned char lds[];
    Frame F;
    F.lds = (LAS unsigned char*)lds;
    F.wave = __builtin_amdgcn_readfirstlane((int)threadIdx.x >> 6);
    F.G = gridDim.x; { const int bx = blockIdx.x; F.vcu = (F.G % 8 == 0) ? (bx % 8) * (F.G / 8) + bx / 8 : bx; }
    F.out = args.out; F.ws = args.ws;
    unsigned char* ws = args.ws;
    gu32* ctl = (gu32*)(ws + WS_CTL);
    for (int u = (int)threadIdx.x; u < (LDS_BYTES - LDSCTL_OFF) / 4; u += NWAVES * 64) ((LAS unsigned*)(F.lds + LDSCTL_OFF))[u] = 0u;
    __syncthreads();
    XcdBarrier bar; bar.bar = (unsigned*)(ctl + CW_BAR); bar.x = 0; bar.st = nullptr;
    if (N_LAUNCHES == 1) bar = xcd_barrier_post((unsigned*)(ctl + CW_BAR), (volatile LAS unsigned*)(F.lds + MISC_OFF) + 8);
#define GRID_BAR() do { if (N_LAUNCHES == 1) xcd_barrier(bar); } while (0)
    const int lo = args.ph_lo, hi = args.ph_hi;
#define IN(k) (lo <= (k) && (k) < hi)
#define BOTH(k) (IN(k) && IN((k) + 1))
    bf16_t* XB = (bf16_t*)(ws + WS_XB); bf16_t* WINT = (bf16_t*)(ws + WS_WIN); bf16_t* GATE = (bf16_t*)(ws + WS_GATE); bf16_t* QKV = (bf16_t*)(ws + WS_QKV);
    bf16_t* OSB = (bf16_t*)(ws + WS_OSB); bf16_t* O1 = (bf16_t*)(ws + WS_O1); bf16_t* O2 = (bf16_t*)(ws + WS_O2);

    if (IN(0)) { const auto* ka = KARGS(); p0_prologue(F, (const float*)ka->in[0], (const int*)ka->in[1], (const float*)ka->in[2], (const float*)ka->in[9], (const float*)ka->in[10], (const float*)ka->in[11], (const float*)ka->in[14], (const float*)ka->in[15]); GRID_BAR(); p0b_weights(F, (const float*)ka->in[2], (const float*)ka->in[9], (const float*)ka->in[10], (const float*)ka->in[11]); if (BOTH(0)) GRID_BAR(); }
    if (IN(1)) {
        pg8::Gemm g{XB, WINT, T_TOK, IN_W, DM / 2}; pg8::StaticOrder S; S.init(T_TOK, IN_W, F.G, (int)blockIdx.x);
        const auto* ka = KARGS(); pg8::EpiProj E{QKV, GATE, (const float*)ka->in[3], (const float*)(ws + WS_ROPEC), (const float*)(ws + WS_ROPES), (const float*)(ws + WS_SX), (const float*)(ws + WS_SW)};
        pg8::gemm_phase<pg8::EpiProj, pg8::StaticOrder, true, true, true>(F.lds + RING_OFF, g, S, E);
        if (BOTH(1)) GRID_BAR();
    }
    if (IN(2)) {
        const int g = (int)blockIdx.x, G = F.G;
        { const DaGetVS get{ws, g, G};
          const int nit = g < 1024 ? (1024 - g + G - 1) / G : 0;
          att::attn_stream_vs<SEQ>(2 * nit, get, (char*)lds + RING_OFF);
          }
        { const SbGet get{ws, g, G};
          const int nb = g < 1024 ? (1024 - g + G - 1) / G : 0;
          att::attn_stream<1>(nb, get, 2048, (char*)lds + RING_OFF);
          }
        if (BOTH(2)) GRID_BAR();
    }
    if (IN(3)) { const auto* ka = KARGS(); p3_combine(F, (const float*)ka->in[4], (const float*)ka->in[5], (const float*)ka->in[6], (const float*)ka->in[7], (const float*)ka->in[8], (const float*)ka->in[16], (const float*)ka->in[17]); if (BOTH(3)) GRID_BAR(); }
    if (IN(4)) {
        pg8::Gemm g{(const bf16_t*)(ws + WS_OSBQ), (const bf16_t*)(ws + WS_WSB), T_TOK, DM, 1024}; pg8::StaticOrder S; S.init(T_TOK, DM, F.G, (int)blockIdx.x);
        pg8::EpiBranch<0> E{GATE, XB, (const float*)(ws + WS_SOSB), (const float*)(ws + WS_SW) + IN_W, nullptr};
        pg8::gemm_phase<pg8::EpiBranch<0>, pg8::StaticOrder, true, true, true>(F.lds + RING_OFF, g, S, E);
    }
    if (IN(5)) {
        pg8::Gemm g{(const bf16_t*)(ws + WS_ODAQ), (const bf16_t*)(ws + WS_WDA), T_TOK, DM, 1024}; pg8::StaticOrder S; S.init(T_TOK, DM, F.G, (int)blockIdx.x);
        pg8::EpiBranch<1> E{GATE, XB, (const float*)(ws + WS_SODA), (const float*)(ws + WS_SW) + IN_W + DM, (unsigned*)(ws + WS_RM)};
        pg8::gemm_phase<pg8::EpiBranch<1>, pg8::StaticOrder, true, true, true>(F.lds + RING_OFF, g, S, E);
        GRID_BAR(); p5b_quant(F);
        if (BOTH(5)) GRID_BAR();
    }
    if (IN(6)) {
        pg8::Gemm g{(const bf16_t*)(ws + WS_MQ), (const bf16_t*)(ws + WS_WOUT), T_TOK, DM, DM / 2}; pg8::StaticOrder S; S.init(T_TOK, DM, F.G, (int)blockIdx.x);
        const auto* ka = KARGS(); pg8::EpiResid E{(const float*)ka->in[0], F.out, (const float*)(ws + WS_SM), (const float*)(ws + WS_SW) + IN_W + 2 * DM};
        pg8::gemm_phase<pg8::EpiResid, pg8::StaticOrder, true, true, true>(F.lds + RING_OFF, g, S, E);
        if (BOTH(6)) GRID_BAR();
    }
    if (IN(7)) { const auto* ka = KARGS(); p7_ln1(F, (const float*)ka->in[12], (const float*)ka->in[13]); if (BOTH(7)) GRID_BAR(); }
    if (IN(8)) {
        pg8::Gemm g{(const bf16_t*)(ws + WS_H1Q), (const bf16_t*)(ws + WS_WPQ), T_TOK, 2048, DM / 2}; pg8::StaticOrder S; S.init(T_TOK, 2048, F.G, (int)blockIdx.x);
        pg8::EpiF32 E{(float*)(ws + WS_XB), 2048, (const float*)(ws + WS_HS), (const float*)(ws + WS_SWP)};
        pg8::gemm_phase<pg8::EpiF32, pg8::StaticOrder, true, true, true>(F.lds + RING_OFF, g, S, E);
        if (BOTH(8)) GRID_BAR();
    }
    if (IN(9)) { p9_topk(F); if (BOTH(9)) GRID_BAR(); }
    if (IN(10)) { { const auto* ka = KARGS(); p10a_dots(F, (const float*)ka->in[12], (const float*)ka->in[13]); } GRID_BAR();
                  { const auto* ka = KARGS(); p10b_axpy(F, (const float*)ka->in[12], (const float*)ka->in[13]); } GRID_BAR();
                  { const auto* ka = KARGS(); p10c_ln2(F, (const float*)ka->in[18], (const float*)ka->in[19]); } }
#undef IN
#undef BOTH
#undef GRID_BAR
}

extern "C" void kernel_launch(void* const* d_in, const int* in_sizes, int n_in, void* d_out, int out_size, void* d_ws, size_t ws_size, hipStream_t stream) {
    static int grid = 0;
    if (grid == 0) {
        if (n_in != 20 || out_size != T_TOK * DM || ws_size < WS_END) { fprintf(stderr, "kernel_launch: built for 20 inputs, out of %d floats, >= %zu bytes of workspace; got n_in %d, out %d, ws %zu; nothing launched\n", T_TOK * DM, (size_t)WS_END, n_in, out_size, ws_size); grid = -1; return; }
        int dev = 0, cus = 0, per_cu = 0;
        if (hipGetDevice(&dev) != hipSuccess || hipDeviceGetAttribute(&cus, hipDeviceAttributeMultiprocessorCount, dev) != hipSuccess) { fprintf(stderr, "kernel_launch: device query failed\n"); grid = -1; return; }
        if (hipFuncSetAttribute((const void*)fwd, hipFuncAttributeMaxDynamicSharedMemorySize, LDS_BYTES) != hipSuccess) { fprintf(stderr, "kernel_launch: hipFuncSetAttribute failed\n"); grid = -1; return; }
        if (hipOccupancyMaxActiveBlocksPerMultiprocessor(&per_cu, (const void*)fwd, NWAVES * 64, LDS_BYTES) != hipSuccess || per_cu < 1)
            fprintf(stderr, "kernel_launch: note: occupancy query reports %d workgroups per CU\n", per_cu);
        (void)hipGetLastError();
        grid = cus;
    }
    if (grid < 0) return;
    if (hipMemsetAsync((char*)d_ws + WS_CTL, 0, CTL_ZERO_BYTES, stream) != hipSuccess) { fprintf(stderr, "kernel_launch: hipMemsetAsync failed\n"); return; }
    Args a{};
    for (int i = 0; i < 20; ++i) a.in[i] = d_in[i];
    a.out = (float*)d_out; a.ws = (unsigned char*)d_ws;
    for (int li = 0; li < N_LAUNCHES; ++li) {
        a.ph_lo = (N_LAUNCHES == 1) ? 0 : li; a.ph_hi = (N_LAUNCHES == 1) ? N_PHASES : li + 1; a.li = li; a.pad = 0;
        hipLaunchKernelGGL(fwd, dim3(grid), dim3(NWAVES * 64), LDS_BYTES, stream, a);
        const hipError_t le = hipPeekAtLastError();
        if (le != hipSuccess) { fprintf(stderr, "kernel_launch: launch %d failed: %s\n", li, hipGetErrorName(le)); break; }
    }
}
```

```cpp
#include <hip/hip_runtime.h>
#include <cstdio>
#include <cstdint>

constexpr int DM = 4096, NBATCH = 4, SEQ = 4096, T_TOK = NBATCH * SEQ;
constexpr int HD = 128, SB_HEADS = 16, DA_HEADS = 8, IN_W = 20480, GATE_W = 8192;
constexpr int P_HEADS = 8, P_KEYS = 128, P_TOPK = 16, P_SEL = 128, P_EXP = 16384;
constexpr float LN_EPS = 1e-5f;
constexpr float DN_ALPHA = 1.189207115002721f;
constexpr float LAM_INIT = 0.2f;
constexpr float QSCALE_SB = 0.08838834764831845f * 1.4426950408889634f;
typedef unsigned short bf16_t;

namespace pg8 {
#define PG8_LAS __attribute__((address_space(3)))
typedef unsigned short bf16_t;
typedef short bf16x8 __attribute__((ext_vector_type(8)));
typedef float f32x4 __attribute__((ext_vector_type(4)));
typedef unsigned u32x4 __attribute__((ext_vector_type(4)));
constexpr int BM = 256, BK = 64, HALF = 128, HTB = HALF * BK * 2  , STAGE_BYTES = 8 * HTB, NXCD = 8, WGM = 8;

__host__ __device__ __forceinline__ int lds_byte(int r, int c) { const int st = (r >> 4) * 2 + (c >> 5), rr = r & 15, cc = c & 31, ob = rr * 64 + cc * 2; return st * 1024 + (ob ^ (((ob >> 9) & 1) << 5)); }
__host__ __device__ __forceinline__ void stage_rc(int b, int& R, int& C) { const int st = b / 1024, sb = b % 1024, swz = sb ^ (((sb >> 9) & 1) << 5); R = (st >> 1) * 16 + swz / 64; C = (st & 1) * 32 + (swz % 64) / 2; }
__host__ __device__ __forceinline__ int perm32(int rho) { const int n = rho >> 4, i = rho & 15; return 8 * (i >> 2) + 4 * n + (i & 3); }

template <bool C, class A, class B> struct pg8_sel { typedef A type; };
template <class A, class B> struct pg8_sel<false, A, B> { typedef B type; };
struct Unit { int pm, pn; };
struct Gemm { const bf16_t* A; const bf16_t* Bt; int M, N, K; };

struct StaticOrder {
    int nM, nN, nwg, G, c;
    __host__ __device__ void init(int M, int N, int G_, int c_) { nM = M / BM; nN = N / BM; nwg = nM * nN; G = G_; c = c_; }
    __host__ __device__ bool next(int i, Unit& u) const {
        const long L = (long)i * G + c; if (L >= nwg) return false;
        int wgid = (int)L; { const int q = nwg / NXCD, r = nwg % NXCD, xcd = wgid % NXCD, off = wgid / NXCD; wgid = (xcd < r ? xcd * (q + 1) : r * (q + 1) + (xcd - r) * q) + off; }
        const int nig = WGM * nN, gid = wgid / nig, fm = gid * WGM, gsz = (nM - fm) < WGM ? (nM - fm) : WGM;
        u.pm = fm + ((wgid % nig) % gsz); u.pn = (wgid % nig) / gsz; return true;
    }
    __device__ __forceinline__ void a_ready(const Unit&) const {}
    __device__ __forceinline__ void done(const Unit&) const {}
};
typedef __bf16 nbf2_t __attribute__((ext_vector_type(2)));
typedef float nf2_t __attribute__((ext_vector_type(2)));
__device__ __forceinline__ unsigned cvt_pk_bf16(float lo, float hi) { const nf2_t v = {lo, hi}; const nbf2_t r = __builtin_convertvector(v, nbf2_t); return __builtin_bit_cast(unsigned, r); }
typedef float f32x2 __attribute__((ext_vector_type(2)));
__device__ __forceinline__ f32x2 gelu_pk(f32x2 v) {
    const f32x2 av = __builtin_elementwise_abs(v), d = av * 0.2316418882f + 1.0f;
    f32x2 t; t.x = __builtin_amdgcn_rcpf(d.x); t.y = __builtin_amdgcn_rcpf(d.y);
    f32x2 q = t * 0.5307027145f + (-0.7265760135f); q = q * t + 0.7107068705f; q = q * t + (-0.142248368f); q = q * t + 0.127414796f; q = q * t;
    const f32x2 s = (v * v) * (-0.72134752044f);
    f32x2 e; e.x = __builtin_amdgcn_exp2f(s.x); e.y = __builtin_amdgcn_exp2f(s.y);
    const f32x2 m = v * (q * e), r = v - m;
    f32x2 o; o.x = v.x < 0.f ? m.x : r.x; o.y = v.y < 0.f ? m.y : r.y; return o;
}
typedef unsigned u32x2_ __attribute__((ext_vector_type(2)));
__device__ __forceinline__ void unpack8(const u32x4 w, f32x4& a, f32x4& b) {
    a[0] = __uint_as_float(w.x << 16); a[1] = __uint_as_float(w.x & 0xffff0000u); a[2] = __uint_as_float(w.y << 16); a[3] = __uint_as_float(w.y & 0xffff0000u);
    b[0] = __uint_as_float(w.z << 16); b[1] = __uint_as_float(w.z & 0xffff0000u); b[2] = __uint_as_float(w.w << 16); b[3] = __uint_as_float(w.w & 0xffff0000u);
}
__device__ __forceinline__ u32x4 pack8f(const f32x4 v0, const f32x4 v1) { u32x4 w; w.x = cvt_pk_bf16(v0[0], v0[1]); w.y = cvt_pk_bf16(v0[2], v0[3]); w.z = cvt_pk_bf16(v1[0], v1[1]); w.w = cvt_pk_bf16(v1[2], v1[3]); return w; }
struct EpiProj {
    static constexpr bool PERM = true, AFTER_DRAIN = false;
    bf16_t* qkv; bf16_t* gate;   const float* bgate; const float* ropec; const float* ropes; const float* sx; const float* sw;
    __device__ __forceinline__ void operator()(const f32x4 (&acc)[2][2][4][2], const Unit& u, int wr, int wc, int fr, int fq) const {
        const int row0 = u.pm * BM + wr * 64 + fr;
        if (u.pn < 48) {
            const int type = u.pn >> 3, hb = (u.pn & 7) * 2;
            bf16_t* base = qkv + (size_t)type * ((size_t)T_TOK * 2048);
            const int b = u.pm >> 4, s0 = (u.pm & 15) * 256 + wr * 64 + fr, d0 = wc * 32 + 8 * fq;
            const bool rope = (type == 3) || (type == 4);
            const float sc = (type == 0) ? QSCALE_SB : 1.f;
            f32x4 cw[2][2];
#pragma unroll
            for (int bj = 0; bj < 2; ++bj)
#pragma unroll
                for (int n = 0; n < 2; ++n) cw[bj][n] = *(const f32x4*)(sw + u.pn * BM + bj * HALF + d0 + 4 * n);
#pragma unroll
            for (int ai = 0; ai < 2; ++ai)
#pragma unroll
                for (int m = 0; m < 4; ++m) {
                    const int s = s0 + ai * HALF + m * 16, row = row0 + ai * HALF + m * 16;
                    const float rs = sx[row] * sc;
                    f32x4 c4 = (f32x4){1.f, 1.f, 1.f, 1.f}, s4 = (f32x4){0.f, 0.f, 0.f, 0.f};
                    if (rope) { c4 = *(const f32x4*)(ropec + (size_t)row * 64 + 4 * (4 * wc + fq)); s4 = *(const f32x4*)(ropes + (size_t)row * 64 + 4 * (4 * wc + fq)); }
#pragma unroll
                    for (int bj = 0; bj < 2; ++bj) {
                        const f32x4 x1 = acc[ai][bj][m][0] * cw[bj][0], x2 = acc[ai][bj][m][1] * cw[bj][1];
                        const f32x4 r0 = (x1 * c4 - x2 * s4) * rs, r1 = (x1 * s4 + x2 * c4) * rs;
                        *(u32x4*)(base + ((size_t)((b * 16 + hb + bj) * SEQ + s)) * 128 + d0) = pack8f(r0, r1);
                    }
                }
        } else {
            const int gc0 = (u.pn - 48) * 256 + wc * 32 + 8 * fq;
            f32x4 bv[2][2], cw[2][2];
#pragma unroll
            for (int bj = 0; bj < 2; ++bj)
#pragma unroll
                for (int n = 0; n < 2; ++n) { bv[bj][n] = *(const f32x4*)(bgate + gc0 + bj * HALF + 4 * n); cw[bj][n] = *(const f32x4*)(sw + 12288 + gc0 + bj * HALF + 4 * n); }
#pragma unroll
            for (int ai = 0; ai < 2; ++ai)
#pragma unroll
                for (int m = 0; m < 4; ++m) {
                    unsigned char* rowp = (unsigned char*)gate + (size_t)(row0 + ai * HALF + m * 16) * GATE_W + gc0;
                    const float rs = sx[row0 + ai * HALF + m * 16];
#pragma unroll
                    for (int bj = 0; bj < 2; ++bj) {
                        f32x4 v0 = acc[ai][bj][m][0] * cw[bj][0] * rs + bv[bj][0], v1 = acc[ai][bj][m][1] * cw[bj][1] * rs + bv[bj][1];
#pragma unroll
                        for (int j = 0; j < 4; ++j) { v0[j] = __builtin_amdgcn_rcpf(1.f + __builtin_amdgcn_exp2f(-1.4426950408889634f * v0[j])); v1[j] = __builtin_amdgcn_rcpf(1.f + __builtin_amdgcn_exp2f(-1.4426950408889634f * v1[j])); }
                        unsigned lo_ = 0u, hi_ = 0u;
#pragma unroll
                        for (int j = 0; j < 4; ++j) { lo_ = __builtin_amdgcn_cvt_pk_u8_f32(v0[j] * 255.f, j, lo_); hi_ = __builtin_amdgcn_cvt_pk_u8_f32(v1[j] * 255.f, j, hi_); }
                        *(u32x2_*)(rowp + bj * HALF) = (u32x2_){lo_, hi_};
                    }
                }
        }
    }
};
template <int SECOND> struct EpiBranch {
    static constexpr bool PERM = true, AFTER_DRAIN = false;
    const bf16_t* gate; bf16_t* out; const float* sa; const float* sw; unsigned* rowmax;
    __device__ __forceinline__ void operator()(const f32x4 (&acc)[2][2][4][2], const Unit& u, int wr, int wc, int fr, int fq) const {
        const int row0 = u.pm * BM + wr * 64 + fr, col0 = u.pn * BM + wc * 32 + 8 * fq;
        f32x4 cw[2][2];
#pragma unroll
        for (int bj = 0; bj < 2; ++bj)
#pragma unroll
            for (int n = 0; n < 2; ++n) cw[bj][n] = *(const f32x4*)(sw + col0 + bj * HALF + 4 * n);
#pragma unroll
        for (int ai = 0; ai < 2; ++ai)
#pragma unroll
            for (int m = 0; m < 4; ++m) {
                const size_t row = (size_t)(row0 + ai * HALF + m * 16);
                const float rs = sa[row] * (1.f / 255.f); float rmx = 0.f;
#pragma unroll
                for (int bj = 0; bj < 2; ++bj) {
                    const int col = col0 + bj * HALF;
                    f32x4 ga, gb; { const u32x2_ gw_ = *(const u32x2_*)((const unsigned char*)gate + row * GATE_W + SECOND * DM + col);
#pragma unroll
                        for (int j = 0; j < 4; ++j) { ga[j] = (float)((gw_.x >> (8 * j)) & 255u); gb[j] = (float)((gw_.y >> (8 * j)) & 255u); } }
                    f32x4 v0 = acc[ai][bj][m][0] * cw[bj][0] * rs * ga, v1 = acc[ai][bj][m][1] * cw[bj][1] * rs * gb;
                    if (SECOND) { f32x4 pa, pb; unpack8(*(const u32x4*)(out + row * DM + col), pa, pb); v0 = v0 + pa; v1 = v1 + pb; }
                    *(u32x4*)(out + row * DM + col) = pack8f(v0, v1);
                    if (SECOND) { const f32x4 a0 = __builtin_elementwise_abs(v0), a1 = __builtin_elementwise_abs(v1);
                        rmx = fmaxf(rmx, fmaxf(fmaxf(fmaxf(a0[0], a0[1]), fmaxf(a0[2], a0[3])), fmaxf(fmaxf(a1[0], a1[1]), fmaxf(a1[2], a1[3])))); }
                }
                if (SECOND) { rmx = fmaxf(rmx, __shfl_xor(rmx, 16)); rmx = fmaxf(rmx, __shfl_xor(rmx, 32));
                    if (fq == 0) atomicMax(rowmax + row, __float_as_uint(rmx)); }
            }
    }
};
struct EpiResid {
    static constexpr bool PERM = false, AFTER_DRAIN = false;
    const float* x; float* y; const float* sa; const float* sw;
    __device__ __forceinline__ void operator()(const f32x4 (&acc)[2][2][4][2], const Unit& u, int wr, int wc, int fr, int fq) const {
        const int row0 = u.pm * BM + wr * 64 + fr, col0 = u.pn * BM + wc * 32 + 4 * fq;
        f32x4 cw[2][2];
#pragma unroll
        for (int bj = 0; bj < 2; ++bj)
#pragma unroll
            for (int n = 0; n < 2; ++n) cw[bj][n] = *(const f32x4*)(sw + col0 + bj * HALF + n * 16);
#pragma unroll
        for (int ai = 0; ai < 2; ++ai)
#pragma unroll
            for (int m = 0; m < 4; ++m) {
                const size_t off = (size_t)(row0 + ai * HALF + m * 16) * DM + col0; const float rs = sa[row0 + ai * HALF + m * 16];
#pragma unroll
                for (int bj = 0; bj < 2; ++bj)
#pragma unroll
                    for (int n = 0; n < 2; ++n) { const f32x4 xv = __builtin_nontemporal_load((const f32x4*)(x + off + bj * HALF + n * 16)); *(f32x4*)(y + off + bj * HALF + n * 16) = xv * DN_ALPHA + acc[ai][bj][m][n] * cw[bj][n] * rs; }
                asm volatile("" ::: "memory");
            }
    }
};
struct EpiF32 {
    static constexpr bool PERM = false, AFTER_DRAIN = false;
    float* C; int ldc; const float* sa; const float* sw;
    __device__ __forceinline__ void operator()(const f32x4 (&acc)[2][2][4][2], const Unit& u, int wr, int wc, int fr, int fq) const {
        const int row0 = u.pm * BM + wr * 64 + fr, col0 = u.pn * BM + wc * 32 + 4 * fq;
        f32x4 cw[2][2];
#pragma unroll
        for (int bj = 0; bj < 2; ++bj)
#pragma unroll
            for (int n = 0; n < 2; ++n) cw[bj][n] = *(const f32x4*)(sw + col0 + bj * HALF + n * 16);
#pragma unroll
        for (int ai = 0; ai < 2; ++ai)
#pragma unroll
            for (int m = 0; m < 4; ++m) { float* rowp = C + (size_t)(row0 + ai * HALF + m * 16) * ldc + col0; const float rs = sa[row0 + ai * HALF + m * 16];
#pragma unroll
                for (int bj = 0; bj < 2; ++bj)
#pragma unroll
                    for (int n = 0; n < 2; ++n) *(f32x4*)(rowp + bj * HALF + n * 16) = acc[ai][bj][m][n] * cw[bj][n] * rs; }
    }
};

template <class Epi, class Sched, bool ALIGN_EPI = false, bool SP2 = false, bool I8 = false>
__device__ __forceinline__ void gemm_phase(PG8_LAS unsigned char* lds, const Gemm g, const Sched& S, const Epi& E) {
    const int tid = threadIdx.x, wid = __builtin_amdgcn_readfirstlane(tid >> 6), lane = tid & 63, wr = wid >> 2, wc = wid & 3, fr = lane & 15, fq = lane >> 4;
    const int K = g.K, nt = K / BK;
    unsigned voffA[2], voffB[2];
#pragma unroll
    for (int i = 0; i < 2; ++i) { int R, C; stage_rc(tid * 16 + i * 8192, R, C); const int Rb = Epi::PERM ? ((R & ~31) + perm32(R & 31)) : R;
        voffA[i] = (unsigned)(R * K + C) * 2u; voffB[i] = (unsigned)(Rb * K + C) * 2u; }
    const size_t kstep = (size_t)(BK * 2);
    const size_t hstep = (size_t)HALF * K * 2;
    const size_t tstep = 2 * hstep;
    const unsigned ldsw = (unsigned)wid * 1024u;
    const int aoff = lds_byte(wr * 64 + fr, fq * 8), boff = lds_byte(wc * 32 + fr, fq * 8);
#define PG8_SA(b, h) (((b) * 2 + (h)) * HTB)
#define PG8_SB(b, h) ((4 + (b) * 2 + (h)) * HTB)
#define PG8_STAGE(bufoff, gbase, voff) do { _Pragma("unroll") for (int _i = 0; _i < 2; ++_i) \
        __builtin_amdgcn_global_load_lds((const unsigned*)((const char*)(gbase) + (voff)[_i]), (PG8_LAS unsigned*)(lds + (bufoff) + ldsw + _i * 8192), 16, 0, 0); } while (0)
#define PG8_LDA(dst, b, h) do { _Pragma("unroll") for (int m = 0; m < 4; ++m) _Pragma("unroll") for (int k = 0; k < 2; ++k) dst[m][k] = *(const PG8_LAS bf16x8*)(lds + PG8_SA(b, h) + aoff + m * 2048 + k * 1024); } while (0)
#define PG8_LDB(dst, b, h) do { _Pragma("unroll") for (int n = 0; n < 2; ++n) _Pragma("unroll") for (int k = 0; k < 2; ++k) dst[n][k] = *(const PG8_LAS bf16x8*)(lds + PG8_SB(b, h) + boff + n * 2048 + k * 1024); } while (0)
#define PG8_MMA(ai, bj, At, Bt) do { __builtin_amdgcn_s_setprio(1); _Pragma("unroll") for (int m = 0; m < 4; ++m) _Pragma("unroll") for (int n = 0; n < 2; ++n) _Pragma("unroll") for (int k = 0; k < 2; ++k) { \
        if constexpr (I8) acc[ai][bj][m][n] = __builtin_amdgcn_mfma_i32_16x16x64_i8(__builtin_bit_cast(i32x4, Bt[n][k]), __builtin_bit_cast(i32x4, At[m][k]), acc[ai][bj][m][n], 0, 0, 0); \
        else acc[ai][bj][m][n] = __builtin_amdgcn_mfma_f32_16x16x32_bf16(Bt[n][k], At[m][k], acc[ai][bj][m][n], 0, 0, 0); } __builtin_amdgcn_s_setprio(0); } while (0)
#define PG8_WAIT_V(n) asm volatile("s_waitcnt vmcnt(" #n ")" ::: "memory")
#define PG8_WAIT_L(n) asm volatile("s_waitcnt lgkmcnt(" #n ")" ::: "memory")
#define PG8_BAR __builtin_amdgcn_s_barrier()
#define PG8_SCHED __builtin_amdgcn_sched_barrier(0)
    Unit cur, nxt; int ui = 0;
    if (!S.next(0, cur)) return;
    typedef int i32x4 __attribute__((ext_vector_type(4)));
    typedef typename pg8_sel<I8, i32x4, f32x4>::type acc_t;
    acc_t acc[2][2][4][2];
#pragma unroll
    for (int a = 0; a < 2; ++a)
#pragma unroll
        for (int b = 0; b < 2; ++b)
#pragma unroll
            for (int m = 0; m < 4; ++m)
#pragma unroll
                for (int n = 0; n < 2; ++n) acc[a][b][m][n] = (acc_t){0, 0, 0, 0};
    bf16x8 At[4][2], B0[2][2], B1[2][2];
    const char* cA = (const char*)g.A + (size_t)cur.pm * tstep; const char* cB = (const char*)g.Bt + (size_t)cur.pn * tstep;
    S.a_ready(cur);
    if constexpr (SP2) {
        PG8_STAGE(PG8_SB(0, 0), cB, voffB); PG8_STAGE(PG8_SB(0, 1), cB + hstep, voffB); PG8_STAGE(PG8_SA(0, 0), cA, voffA); PG8_STAGE(PG8_SA(0, 1), cA + hstep, voffA);
        if (wr == 1) PG8_BAR;
        PG8_WAIT_V(2); PG8_BAR;
        PG8_STAGE(PG8_SB(1, 0), cB + kstep, voffB); PG8_STAGE(PG8_SA(1, 0), cA + kstep, voffA); PG8_STAGE(PG8_SB(1, 1), cB + hstep + kstep, voffB);
        PG8_WAIT_V(6); PG8_BAR;
    } else {
        PG8_STAGE(PG8_SB(0, 0), cB, voffB); PG8_STAGE(PG8_SA(0, 0), cA, voffA); PG8_STAGE(PG8_SB(0, 1), cB + hstep, voffB); PG8_STAGE(PG8_SA(0, 1), cA + hstep, voffA);
        if (wr == 1) PG8_BAR;
        PG8_WAIT_V(4); PG8_BAR;
        PG8_STAGE(PG8_SB(1, 0), cB + kstep, voffB); PG8_STAGE(PG8_SA(1, 0), cA + kstep, voffA); PG8_STAGE(PG8_SB(1, 1), cB + hstep + kstep, voffB);
        PG8_WAIT_V(6); PG8_BAR;
    }
    for (;;) {
        const bool has_next = S.next(ui + 1, nxt);
        const char* nA = has_next ? (const char*)g.A + (size_t)nxt.pm * tstep : cA; const char* nB = has_next ? (const char*)g.Bt + (size_t)nxt.pn * tstep : cB;
        for (int t = 0; t < nt; t += 2) {
            const bool last = (t == nt - 2);
            const char* a1 = cA + (size_t)(t + 1) * kstep;
            const char* a2 = last ? nA : cA + (size_t)(t + 2) * kstep; const char* b2 = last ? nB : cB + (size_t)(t + 2) * kstep;
            const char* a3 = a2 + kstep; const char* b3 = b2 + kstep;
            if (last && has_next) S.a_ready(nxt);
            if constexpr (SP2) {
            PG8_LDB(B0, 0, 0); PG8_LDB(B1, 0, 1); PG8_SCHED; PG8_LDA(At, 0, 0); PG8_STAGE(PG8_SA(1, 1), a1 + hstep, voffA);
            PG8_WAIT_V(8); PG8_WAIT_L(0); PG8_BAR; PG8_MMA(0, 0, At, B0); PG8_MMA(0, 1, At, B1); PG8_BAR; PG8_SCHED;
            PG8_LDA(At, 0, 1); PG8_STAGE(PG8_SB(0, 0), b2, voffB); PG8_STAGE(PG8_SB(0, 1), b2 + hstep, voffB); PG8_STAGE(PG8_SA(0, 0), a2, voffA);
            PG8_WAIT_V(8); PG8_WAIT_L(0); PG8_BAR; PG8_MMA(1, 0, At, B0); PG8_MMA(1, 1, At, B1); PG8_BAR; PG8_SCHED;
            PG8_LDB(B0, 1, 0); PG8_LDB(B1, 1, 1); PG8_SCHED; PG8_LDA(At, 1, 0); PG8_STAGE(PG8_SA(0, 1), a2 + hstep, voffA);
            PG8_WAIT_V(8); PG8_WAIT_L(0); PG8_BAR; PG8_MMA(0, 0, At, B0); PG8_MMA(0, 1, At, B1); PG8_BAR; PG8_SCHED;
            PG8_LDA(At, 1, 1); PG8_STAGE(PG8_SB(1, 0), b3, voffB); PG8_STAGE(PG8_SB(1, 1), b3 + hstep, voffB); PG8_STAGE(PG8_SA(1, 0), a3, voffA);
            PG8_WAIT_V(8); PG8_WAIT_L(0); PG8_BAR; PG8_MMA(1, 0, At, B0); PG8_MMA(1, 1, At, B1); PG8_BAR; PG8_SCHED;
            } else {
            PG8_LDB(B0, 0, 0); PG8_SCHED; PG8_LDA(At, 0, 0); PG8_STAGE(PG8_SA(1, 1), a1 + hstep, voffA);
            PG8_WAIT_L(8); PG8_BAR; PG8_WAIT_L(0); PG8_MMA(0, 0, At, B0); PG8_BAR; PG8_SCHED;
            PG8_LDB(B1, 0, 1); PG8_STAGE(PG8_SB(0, 0), b2, voffB);
            PG8_BAR; PG8_WAIT_L(0); PG8_MMA(0, 1, At, B1); PG8_BAR;
            PG8_LDA(At, 0, 1); PG8_STAGE(PG8_SA(0, 0), a2, voffA);
            PG8_BAR; PG8_WAIT_L(0); PG8_MMA(1, 0, At, B0); PG8_BAR; PG8_SCHED;
            PG8_STAGE(PG8_SB(0, 1), b2 + hstep, voffB);
            PG8_WAIT_V(6); PG8_BAR; PG8_MMA(1, 1, At, B1); PG8_BAR;
            PG8_LDB(B0, 1, 0); PG8_SCHED; PG8_LDA(At, 1, 0); PG8_STAGE(PG8_SA(0, 1), a2 + hstep, voffA);
            PG8_WAIT_L(8); PG8_BAR; PG8_WAIT_L(0); PG8_MMA(0, 0, At, B0); PG8_BAR; PG8_SCHED;
            PG8_LDB(B1, 1, 1); PG8_STAGE(PG8_SB(1, 0), b3, voffB);
            PG8_BAR; PG8_WAIT_L(0); PG8_MMA(0, 1, At, B1); PG8_BAR;
            PG8_LDA(At, 1, 1); PG8_STAGE(PG8_SA(1, 0), a3, voffA);
            PG8_BAR; PG8_WAIT_L(0); PG8_MMA(1, 0, At, B0); PG8_BAR; PG8_SCHED;
            PG8_STAGE(PG8_SB(1, 1), b3 + hstep, voffB);
            PG8_WAIT_V(6); PG8_BAR; PG8_MMA(1, 1, At, B1); PG8_BAR;
            }
        }
        if constexpr (ALIGN_EPI) { if (wr == 0) PG8_BAR; }
        if constexpr (!Epi::AFTER_DRAIN) {
            if constexpr (I8) { f32x4 accf[2][2][4][2];
#pragma unroll
                for (int a = 0; a < 2; ++a)
#pragma unroll
                    for (int b = 0; b < 2; ++b)
#pragma unroll
                        for (int m = 0; m < 4; ++m)
#pragma unroll
                            for (int n = 0; n < 2; ++n) accf[a][b][m][n] = __builtin_convertvector(acc[a][b][m][n], f32x4);
                E(accf, cur, wr, wc, fr, fq); }
            else E(acc, cur, wr, wc, fr, fq);
            S.done(cur); }
        if (!has_next) break;
#pragma unroll
        for (int a = 0; a < 2; ++a)
#pragma unroll
            for (int b = 0; b < 2; ++b)
#pragma unroll
                for (int m = 0; m < 4; ++m)
#pragma unroll
                    for (int n = 0; n < 2; ++n) acc[a][b][m][n] = (acc_t){0, 0, 0, 0};
        cur = nxt; cA = nA; cB = nB; ++ui;
        if constexpr (ALIGN_EPI) { if (wr == 1) PG8_BAR; }
    }
    PG8_WAIT_V(0);
    if constexpr (!ALIGN_EPI) { if (wr == 0) PG8_BAR; }
    PG8_BAR;
    static_assert(!Epi::AFTER_DRAIN, "no AFTER_DRAIN epilogue in this kernel");
#undef PG8_SA
#undef PG8_SB
#undef PG8_STAGE
#undef PG8_LDA
#undef PG8_LDB
#undef PG8_MMA
#undef PG8_WAIT_V
#undef PG8_WAIT_L
#undef PG8_BAR
#undef PG8_SCHED
}
}
#ifndef EXP_NOEXIT
#define EXP_NOEXIT 0
#endif
namespace att {
constexpr int D = 128, NW = 8, QBLK = 32, KVBLK = 64, QB = NW * QBLK;
constexpr int SHM_V = KVBLK * D * 2, SHM_K = KVBLK * D * 2;
constexpr int LDS_FLAGS = 2 * SHM_V + 2 * SHM_K + NW * 64 * 4;
constexpr int LDS_BYTES = LDS_FLAGS + 128;
constexpr float SCALE = 0.08838834764831845f, THR = 8.f, SB_THR = 48.f;
typedef short bf16x8 __attribute__((ext_vector_type(8)));
typedef short s16x4 __attribute__((ext_vector_type(4)));
typedef float f32x16 __attribute__((ext_vector_type(16)));
typedef float f32x4 __attribute__((ext_vector_type(4)));
typedef unsigned u32x4 __attribute__((ext_vector_type(4)));
#define KSWZ(row, colB) ((row) * 256 + ((colB) ^ (((row) & 7) << 4)))
#define SBAR() __builtin_amdgcn_sched_barrier(0)
__device__ __forceinline__ int v_st(int k, int c) { const int kk = (k & ~0xC) | ((k & 4) << 1) | ((k & 8) >> 1); return ((kk >> 3) * 4 + (c >> 5)) * 512 + ((kk & 7) * 32 + (c & 31)) * 2; }
__device__ __forceinline__ int v_rd_base(int lane) { return ((lane & 3) << 3) | (((lane >> 2) & 3) << 6) | (((lane >> 4) & 1) << 5) | (((lane >> 5) & 1) << 8); }
constexpr int v_rd_off(int d0, int ks, int half) { return d0 * 512 + ks * 4096 + half * 2048; }
__device__ __forceinline__ int crow(int r, int hi) { return (r & 3) + 8 * (r >> 2) + 4 * hi; }
__device__ __forceinline__ unsigned cvtpk(float lo, float hi) { return pg8::cvt_pk_bf16(lo, hi); }
__device__ __forceinline__ bf16x8 load8(const bf16_t* p) { return *reinterpret_cast<const bf16x8*>(p); }
__device__ __forceinline__ bf16x8 load8o(const bf16_t* base, unsigned boff) { return *reinterpret_cast<const bf16x8*>(reinterpret_cast<const char*>(base) + boff); }
__device__ __forceinline__ void mask_tile(f32x16& p0, f32x16& p1, int dq, unsigned W) {
    const float NEG = -__builtin_inff();
#pragma unroll
    for (int r = 0; r < 16; ++r) {
        const int c = (r & 3) + 8 * (r >> 2);
        if ((unsigned)(dq - c) >= W) p0[r] = NEG;
        if ((unsigned)(dq - c - 32) >= W) p1[r] = NEG;
    }
}
__device__ __forceinline__ void partialSM(f32x16& p0, f32x16& p1, float& m_reg, float& mn, float& alpha) {
    float pmax = p0[0]; for (int r = 1; r < 16; ++r) pmax = fmaxf(pmax, p0[r]); for (int r = 0; r < 16; ++r) pmax = fmaxf(pmax, p1[r]);
    { auto rr = __builtin_amdgcn_permlane32_swap(__float_as_uint(pmax), __float_as_uint(pmax), false, false);
      pmax = fmaxf(__uint_as_float(rr[0]), __uint_as_float(rr[1])); }
    constexpr float C2 = 1.4426950408889634f * SCALE;
    if (__builtin_expect(__all((pmax - m_reg) * SCALE <= THR), 1)) { mn = m_reg; alpha = 1.f; }
    else { mn = fmaxf(m_reg, pmax); alpha = __builtin_amdgcn_exp2f((m_reg - mn) * C2); m_reg = mn; }
    const float mnL = -mn * C2;
    for (int r = 0; r < 16; ++r) p0[r] = fmaf(p0[r], C2, mnL); for (int r = 0; r < 16; ++r) p1[r] = fmaf(p1[r], C2, mnL);
    for (int r = 0; r < 16; ++r) p0[r] = __builtin_amdgcn_exp2f(p0[r]);
}
#define PK4(P, B_, OUT) do { unsigned a0 = cvtpk(P[B_+0], P[B_+1]), a1 = cvtpk(P[B_+2], P[B_+3]);                          \
        unsigned b0 = cvtpk(P[B_+4], P[B_+5]), b1 = cvtpk(P[B_+6], P[B_+7]);                                             \
        auto r0 = __builtin_amdgcn_permlane32_swap(a0, b0, false, false); auto r1 = __builtin_amdgcn_permlane32_swap(a1, b1, false, false); \
        u32x4 w = {r0[0], r1[0], r0[1], r1[1]}; OUT = *reinterpret_cast<bf16x8*>(&w); } while (0)
__device__ __forceinline__ void finishSM(f32x16& p0, f32x16& p1, float alpha, float& l_reg, bf16x8& pa0, bf16x8& pa1, bf16x8& pa2, bf16x8& pa3) {
    for (int r = 0; r < 16; ++r) p1[r] = __builtin_amdgcn_exp2f(p1[r]);
    float ps = 0; for (int r = 0; r < 16; ++r) ps += p0[r]; for (int r = 0; r < 16; ++r) ps += p1[r];
    { auto rr = __builtin_amdgcn_permlane32_swap(__float_as_uint(ps), __float_as_uint(ps), false, false);
      ps = __uint_as_float(rr[0]) + __uint_as_float(rr[1]); }
    l_reg = l_reg * alpha + ps;
    PK4(p0, 0, pa0); PK4(p0, 8, pa1); PK4(p1, 0, pa2); PK4(p1, 8, pa3);
}
__device__ __forceinline__ float sp2f(float z) { return fmaxf(z, 0.f) + __builtin_amdgcn_logf(1.f + __builtin_amdgcn_exp2f(-__builtin_fabsf(z))); }
__device__ __forceinline__ void sb_group(float& z0, float& z1, float& z2, float& z3, float& suf, int hi) {
    asm volatile("" : "+v"(suf), "+v"(z0), "+v"(z1), "+v"(z2), "+v"(z3));
    const float s0 = sp2f(z0), s1 = sp2f(z1), s2 = sp2f(z2), s3 = sp2f(z3);
    const float G = (s0 + s1) + (s2 + s3);
    auto rr = __builtin_amdgcn_permlane32_swap(__float_as_uint(G), __float_as_uint(G), false, false);
    const float oth = hi ? __uint_as_float(rr[0]) : __uint_as_float(rr[1]);
    float run = suf + (hi ? 0.f : oth);
    run += s3; z3 -= run; run += s2; z2 -= run; run += s1; z1 -= run; run += s0; z0 -= run;
    suf += hi ? (oth + G) : (G + oth);
}
__device__ __forceinline__ void sb_partial(f32x16& p0, f32x16& p1, float& R, int hi) {
#pragma unroll
    for (int i = 3; i >= 0; --i) { float a = p1[4 * i], b = p1[4 * i + 1], c = p1[4 * i + 2], d = p1[4 * i + 3]; sb_group(a, b, c, d, R, hi); p1[4 * i] = a; p1[4 * i + 1] = b; p1[4 * i + 2] = c; p1[4 * i + 3] = d; }
#pragma unroll
    for (int i = 3; i >= 0; --i) { float a = p0[4 * i], b = p0[4 * i + 1], c = p0[4 * i + 2], d = p0[4 * i + 3]; sb_group(a, b, c, d, R, hi); p0[4 * i] = a; p0[4 * i + 1] = b; p0[4 * i + 2] = c; p0[4 * i + 3] = d; }
}
__device__ __forceinline__ void sb_finish(f32x16& p0, f32x16& p1, bf16x8& pa0, bf16x8& pa1, bf16x8& pa2, bf16x8& pa3) {
    for (int r = 0; r < 16; ++r) p0[r] = __builtin_amdgcn_exp2f(p0[r]);
    for (int r = 0; r < 16; ++r) p1[r] = __builtin_amdgcn_exp2f(p1[r]);
    PK4(p0, 0, pa0); PK4(p0, 8, pa1); PK4(p1, 0, pa2); PK4(p1, 8, pa3);
}
#undef PK4
#ifdef EXP_NOPART
#define SBX_PARTIAL(a,b,c,d) do { (c) += (a)[0]; } while (0)
#else
#define SBX_PARTIAL(a,b,c,d) sb_partial(a,b,c,d)
#endif
template <int KB>
__device__ __forceinline__ void qkt(f32x16& p0, f32x16& p1, const char* K_lds, int r32, int hi, const bf16x8* qr) {
    p0 = f32x16{}; p1 = f32x16{};
    const char* kb[4];
#pragma unroll
    for (int dd = 0; dd < 4; ++dd) kb[dd] = K_lds + KB * SHM_K + KSWZ(r32, (dd * 16 + hi * 8) * 2);
#pragma unroll
    for (int d0 = 0; d0 < 8; ++d0) { const char* a = kb[d0 & 3] + (d0 >> 2) * 128;
        bf16x8 b0 = *reinterpret_cast<const bf16x8*>(a);
        bf16x8 b1 = *reinterpret_cast<const bf16x8*>(a + 32 * 256);
        p0 = __builtin_amdgcn_mfma_f32_32x32x16_bf16(b0, qr[d0], p0, 0, 0, 0);
        p1 = __builtin_amdgcn_mfma_f32_32x32x16_bf16(b1, qr[d0], p1, 0, 0, 0); }
}
template <int VB>
__device__ __forceinline__ void pv_tile(f32x16* o, int vb0, bf16x8 pa0, bf16x8 pa1, bf16x8 pa2, bf16x8 pa3) {
#define TRRD(dst, off) asm volatile("ds_read_b64_tr_b16 %0, %1 offset:%2" : "=&v"(dst) : "v"(vb0), "i"(off) : "memory")
#define PV_D0(d0) do { s16x4 l0, l1, l2, l3, h0, h1, h2, h3; constexpr int b_ = VB * SHM_V + v_rd_off(d0, 0, 0); \
        TRRD(l0, b_); TRRD(h0, b_ + 2048); TRRD(l1, b_ + 4096); TRRD(h1, b_ + 6144); TRRD(l2, b_ + 8192); TRRD(h2, b_ + 10240); TRRD(l3, b_ + 12288); TRRD(h3, b_ + 14336); \
        asm volatile("s_waitcnt lgkmcnt(0)" ::: "memory"); SBAR();   \
        o[d0] = __builtin_amdgcn_mfma_f32_32x32x16_bf16(pa0, (bf16x8){l0[0], l0[1], l0[2], l0[3], h0[0], h0[1], h0[2], h0[3]}, o[d0], 0, 0, 0);   \
        o[d0] = __builtin_amdgcn_mfma_f32_32x32x16_bf16(pa1, (bf16x8){l1[0], l1[1], l1[2], l1[3], h1[0], h1[1], h1[2], h1[3]}, o[d0], 0, 0, 0);   \
        o[d0] = __builtin_amdgcn_mfma_f32_32x32x16_bf16(pa2, (bf16x8){l2[0], l2[1], l2[2], l2[3], h2[0], h2[1], h2[2], h2[3]}, o[d0], 0, 0, 0);   \
        o[d0] = __builtin_amdgcn_mfma_f32_32x32x16_bf16(pa3, (bf16x8){l3[0], l3[1], l3[2], l3[3], h3[0], h3[1], h3[2], h3[3]}, o[d0], 0, 0, 0); } while (0)
    PV_D0(0); PV_D0(1); PV_D0(2); PV_D0(3);
#undef PV_D0
#undef TRRD
}
struct BlockRef { const bf16_t* Q; const bf16_t* K; const bf16_t* V; bf16_t* O; int P0; };
struct Seam { bf16x8 qr[8]; bf16x8 st_v0, st_v1, st_k0, st_k1; };
template <int MODE> __device__ __forceinline__ int first_tile(int P0) { return MODE == 1 ? (P0 + QB - 1) / KVBLK : 0; }
#define ROWB(k0, rr) ((unsigned)((((k0) + (rr)) * D + sc) * 2))
#define VMW() asm volatile("s_waitcnt vmcnt(0)" ::: "memory")
#define VMWN(n) asm volatile("s_waitcnt vmcnt(%0)" :: "i"(n) : "memory")
#define SLOAD_H(Kp, Vp, k0) do { S.st_v0 = load8o(Vp, ROWB(k0, sr)); S.st_v1 = load8o(Vp, ROWB(k0, 32 + sr));              \
                         S.st_k0 = load8o(Kp, ROWB(k0, sr)); S.st_k1 = load8o(Kp, ROWB(k0, 32 + sr)); } while (0)
#define SWRITE_HK(bf) do { *(bf16x8*)(K_lds + (bf) * SHM_K + kws) = S.st_k0; *(bf16x8*)(K_lds + (bf) * SHM_K + kws + 32 * 256) = S.st_k1; } while (0)
#define SWRITE_HV(bf) do { *(bf16x8*)(V_lds + (bf) * SHM_V + vst0) = S.st_v0; *(bf16x8*)(V_lds + (bf) * SHM_V + vst1) = S.st_v1; } while (0)
#define SWRITE_H(bf) do { SWRITE_HV(bf); SWRITE_HK(bf); } while (0)
template <int MODE>
__device__ __forceinline__ void attn_prime(const BlockRef& cur, char* lds, Seam& S, const int tid) {
    const int  wid = __builtin_amdgcn_readfirstlane(tid >> 6), lane = tid & 63, r32 = lane & 31, hi = lane >> 5;
    const int sr = tid >> 4, sc = (tid & 15) * 8, kws = KSWZ(sr, sc * 2); char* K_lds = lds + 2 * SHM_V;
    const int kb0 = first_tile<MODE>(cur.P0) * KVBLK;
    for (int d0 = 0; d0 < 8; ++d0) S.qr[d0] = load8o(cur.Q, (unsigned)(((wid * QBLK + r32) * D + d0 * 16 + hi * 8) * 2));
    SLOAD_H(cur.K, cur.V, kb0); VMW(); SWRITE_HK(0);
    __syncthreads();
}
template <int MODE>
__device__ __forceinline__ void attn_block(const BlockRef& cur, const BlockRef& nxt, int  , char* lds, Seam& S, const int tid) {
    constexpr int ldo = 2048;
    const int  wid = __builtin_amdgcn_readfirstlane(tid >> 6), lane = tid & 63, r32 = lane & 31, hi = lane >> 5;
    const int j_hi = (cur.P0 + QB - 1) / KVBLK + 1;
    int NT = j_hi;
    const int kbn = first_tile<MODE>(nxt.P0) * KVBLK;
    const int qlo = cur.P0 + wid * QBLK, qm = qlo + r32 - 4 * hi;
    char* V_lds = lds; char* K_lds = lds + 2 * SHM_V;
    float* ws = (float*)(lds + 2 * SHM_V + 2 * SHM_K) + wid * 64; float* li_l = ws, * al_l = ws + 32;
    __attribute__((address_space(3))) int* flags = (__attribute__((address_space(3))) int*)(lds + LDS_FLAGS);
    float m_reg = -1e30f, l_reg = 0; f32x16 o[4] = {};
    float Rc = 0.f;
    const int sr = tid >> 4, sc = (tid & 15) * 8, vst0 = v_st(sr, sc), vst1 = vst0 + 8192  , kws = KSWZ(sr, sc * 2);
    const int vb0 = (int)(uintptr_t)V_lds + v_rd_base(lane);
    const bf16_t* Kh = cur.K; const bf16_t* Vh = cur.V;
#define RESC(a) do { if (MODE == 0) { if (__any((a) < 1.f)) { if (hi == 0) al_l[r32] = (a); asm volatile("s_waitcnt lgkmcnt(0)" ::: "memory");              \
                     for (int d_ = 0; d_ < 4; ++d_) for (int r = 0; r < 16; ++r) o[d_][r] *= al_l[crow(r, hi)]; } } } while (0)
#define KBASE(t) ((MODE == 1 ? (j_hi - 1 - (t)) : (t)) * KVBLK)
#define MASKT(P0_, P1_, t) do { const int kb_ = KBASE(t); if (MODE == 0) { if (kb_ + KVBLK - 1 > qlo) mask_tile(P0_, P1_, qm - kb_, 0x40000000u); }             \
                                else { if (kb_ + KVBLK - 1 >= qlo) mask_tile(P0_, P1_, qm - 1 - kb_, 0x40000000u); } } while (0)
#define PART(P0_, P1_, mnX, alX, fs) do { if (MODE == 0) partialSM(P0_, P1_, m_reg, mnX, alX); else { SBAR(); SBX_PARTIAL(P0_, P1_, Rc, hi); \
                                      const int dn_ = __all(Rc > SB_THR) ? 1 : 0; if (lane == 0) flags[(fs) * 8 + wid] = dn_; } } while (0)
#define FIN(P0_, P1_, alY) do { if (MODE == 0) finishSM(P0_, P1_, alY, l_reg, pa0, pa1, pa2, pa3); else sb_finish(P0_, P1_, pa0, pa1, pa2, pa3); } while (0)
    constexpr int NQL = 8;
#define SEAM_K0() do { VMWN(NQL); SWRITE_HK(0); SBAR(); } while (0)
    f32x16 pA0, pA1, pB0, pB1; float mnA = 0.f, mnB = 0.f, alA = 1.f, alB = 1.f; bf16x8 pa0, pa1, pa2, pa3;
    SWRITE_HV(0); SBAR();
    if (NT > 1) SLOAD_H(Kh, Vh, KBASE(1));
    SBAR(); qkt<0>(pA0, pA1, K_lds, r32, hi, S.qr);
    MASKT(pA0, pA1, 0); PART(pA0, pA1, mnA, alA, 2);
    if (NT > 1) { VMW(); SWRITE_H(1); }
    __syncthreads();
#define HALF_STEP(PX0, PX1, mnX, alX, PY0, PY1, alY, t, KB, VB, SB, fs) do {                                                      \
        SBAR(); qkt<KB>(PX0, PX1, K_lds, r32, hi, S.qr);                                                                     \
        FIN(PY0, PY1, alY); SBAR();                                                                                           \
        if ((t) + 1 < NT) { SLOAD_H(Kh, Vh, KBASE((t) + 1)); SBAR(); }                                                        \
        pv_tile<VB>(o, vb0, pa0, pa1, pa2, pa3); MASKT(PX0, PX1, (t)); PART(PX0, PX1, mnX, alX, fs);                          \
        __syncthreads();                                                                                                      \
        if ((t) + 1 < NT) { VMW(); SWRITE_H(SB); }                                                                            \
        RESC(alX); __syncthreads(); } while (0)
    for (int t = 1; t + 1 < NT; t += 2) {
        const int fsl = (t >> 1) & 1;
        HALF_STEP(pB0, pB1, mnB, alB, pA0, pA1, alA, t, 1, 0, 0, 2);
        HALF_STEP(pA0, pA1, mnA, alA, pB0, pB1, alB, t + 1, 0, 1, 1, fsl);
        if (MODE == 1 && !EXP_NOEXIT) {
            typedef int v4i_ __attribute__((ext_vector_type(4)));
            const __attribute__((address_space(3))) v4i_* f_ = (const __attribute__((address_space(3))) v4i_*)(lds + LDS_FLAGS + fsl * 32);
            const v4i_ fa_ = f_[0], fb_ = f_[1];
            const int all_ = __builtin_amdgcn_readfirstlane((fa_.x & fa_.y & fa_.z & fa_.w) & (fb_.x & fb_.y & fb_.z & fb_.w));
#ifdef EXP_FAKEALL
            if (cur.P0 == 12345 + t) NT = t + 2;
#else
            if (all_) NT = t + 2;
#endif
        }
    }
    const bool even = (NT & 1) == 0;
    if (even) { SBAR(); qkt<1>(pB0, pB1, K_lds, r32, hi, S.qr); SBAR(); }
    SLOAD_H(nxt.K, nxt.V, kbn); SBAR();
#pragma unroll
    for (int d0 = 0; d0 < 8; ++d0) S.qr[d0] = load8o(nxt.Q, (unsigned)(((wid * QBLK + r32) * D + d0 * 16 + hi * 8) * 2));
    SBAR();
    FIN(pA0, pA1, alA); SBAR();
    pv_tile<0>(o, vb0, pa0, pa1, pa2, pa3);
    if (even) { MASKT(pB0, pB1, NT - 1); PART(pB0, pB1, mnB, alB, 2); __syncthreads(); RESC(alB);
        FIN(pB0, pB1, alB); SBAR(); pv_tile<1>(o, vb0, pa0, pa1, pa2, pa3); }
    SBAR(); SEAM_K0();
    float rli[16];
    if (MODE == 0) { if (hi == 0) li_l[r32] = l_reg; asm volatile("s_waitcnt lgkmcnt(0)" ::: "memory");
#pragma unroll
        for (int r = 0; r < 16; ++r) rli[r] = __builtin_amdgcn_rcpf(li_l[crow(r, hi)]); }
    else {
#pragma unroll
        for (int r = 0; r < 16; ++r) rli[r] = 1.f; }
    const unsigned obase = (unsigned)((wid * QBLK + 4 * hi) * ldo + r32);
#pragma unroll
    for (int r = 0; r < 16; ++r) { const int orow0 = (r & 3) + 8 * (r >> 2);
#pragma unroll
        for (int d0 = 0; d0 < 4; ++d0) { const float v = o[d0][r] * rli[r];
            const float vn = __shfl_xor(v, 1);
            if ((r32 & 1) == 0) *(unsigned*)(reinterpret_cast<char*>(cur.O) + ((obase + (unsigned)(orow0 * ldo + d0 * 32)) * 2u)) = cvtpk(v, vn); } }
    __syncthreads();
#undef RESC
#undef KBASE
#undef MASKT
#undef PART
#undef FIN
#undef SEAM_K0
#undef HALF_STEP
}
constexpr int VS_QB = 128;
constexpr int VS_K = 4 * SHM_V, VS_P = VS_K + 2 * SHM_K, VS_SMALL = 131072 + 4096;
static_assert(VS_P + 4 * 2 * 4096 <= 131072, "LDS map of the shared-softmax attention");
struct BlockRefVS { const bf16_t* Q; const bf16_t* K; const bf16_t* Vlo; bf16_t* O; int P0; };
#define VSBAR() do { asm volatile("s_waitcnt lgkmcnt(0)" ::: "memory"); __builtin_amdgcn_s_barrier(); asm volatile("" ::: "memory"); } while (0)
__device__ __forceinline__ void vs_store(const f32x16* o, const float* li_w, bf16_t* O, int pw, int r32, int hi, int coff) {
    constexpr int ldo = 2048;
    float rli[16];
#pragma unroll
    for (int r = 0; r < 16; ++r) rli[r] = __builtin_amdgcn_rcpf(li_w[crow(r, hi)]);
    const unsigned obase = (unsigned)((pw * QBLK + 4 * hi) * ldo + r32 + coff);
#pragma unroll
    for (int r = 0; r < 16; ++r) { const int orow0 = (r & 3) + 8 * (r >> 2);
#pragma unroll
        for (int d0 = 0; d0 < 4; ++d0) { const float v = o[d0][r] * rli[r];
            const float vn = __builtin_bit_cast(float, __builtin_amdgcn_update_dpp(0, __builtin_bit_cast(int, v), 0xB1, 0xF, 0xF, true));
            if ((r32 & 1) == 0) *(unsigned*)(reinterpret_cast<char*>(O) + ((obase + (unsigned)(orow0 * ldo + d0 * 32)) * 2u)) = cvtpk(v, vn); } }
}
__device__ __forceinline__ void partialSM_bf(f32x16& p0, f32x16& p1, float& m_reg, float& alpha) {
    float pmax = p0[0]; for (int r = 1; r < 16; ++r) pmax = fmaxf(pmax, p0[r]); for (int r = 0; r < 16; ++r) pmax = fmaxf(pmax, p1[r]);
    { auto rr = __builtin_amdgcn_permlane32_swap(__float_as_uint(pmax), __float_as_uint(pmax), false, false);
      pmax = fmaxf(__uint_as_float(rr[0]), __uint_as_float(rr[1])); }
    constexpr float C2 = 1.4426950408889634f * SCALE;
    const float mn = ((pmax - m_reg) * SCALE <= THR) ? m_reg : fmaxf(m_reg, pmax);
    alpha = __builtin_amdgcn_exp2f((m_reg - mn) * C2); m_reg = mn;
    const float mnL = -mn * C2;
    for (int r = 0; r < 16; ++r) p0[r] = fmaf(p0[r], C2, mnL); for (int r = 0; r < 16; ++r) p1[r] = fmaf(p1[r], C2, mnL);
    for (int r = 0; r < 16; ++r) p0[r] = __builtin_amdgcn_exp2f(p0[r]);
}
__device__ __forceinline__ void vs_producer(const BlockRefVS& cur, char* lds, int pw, int lane, int pt, int NT) {
    asm volatile("" : "+v"(lane), "+v"(pt));
    const int r32 = lane & 31, hi = lane >> 5;
    const int qlo = cur.P0 + pw * QBLK, qm = qlo + r32 - 4 * hi;
    char* K_lds = lds + VS_K; char* P_w = lds + VS_P + pw * 8192;
    const int sr = pt >> 4, sc = (pt & 15) * 8, kws = KSWZ(sr, sc * 2); const unsigned rof0 = ROWB(0, sr); const bf16_t* Kh = cur.K;
    bf16x8 st_k[4];
    char* V_lds = lds; const int vst0 = v_st(sr, sc); const bf16_t* Vl = cur.Vlo;
#define PLOADV(t) do { const size_t to_ = (size_t)(t) * (KVBLK * D); _Pragma("unroll") for (int i_ = 0; i_ < 4; ++i_) st_l[i_] = load8o(Vl + to_, rof0 + i_ * (16 * D * 2)); } while (0)
#define PWRITEV(bf) do { _Pragma("unroll") for (int i_ = 0; i_ < 4; ++i_) *(bf16x8*)(V_lds + (bf) * SHM_V + vst0 + i_ * 4096) = st_l[i_]; } while (0)
#define PLOADK(t) do { const size_t to_ = (size_t)(t) * (KVBLK * D); _Pragma("unroll") for (int i_ = 0; i_ < 4; ++i_) st_k[i_] = load8o(Kh + to_, rof0 + i_ * (16 * D * 2)); } while (0)
#define PWRITEK(bf) do { _Pragma("unroll") for (int i_ = 0; i_ < 4; ++i_) *(bf16x8*)(K_lds + (bf) * SHM_K + kws + i_ * (16 * 256)) = st_k[i_]; } while (0)
    float* al_w = (float*)(lds + VS_SMALL) + pw * 128; float* li_w = al_w + 64; float* fl_w = al_w + 96;
    float m_reg = -1e30f, l_reg = 0;
    bf16x8 qr[8]; f32x16 pA0, pA1, pB0, pB1; float al = 1.f; bf16x8 pa0, pa1, pa2, pa3;
    for (int d0 = 0; d0 < 8; ++d0) qr[d0] = load8o(cur.Q, (unsigned)(((pw * QBLK + r32) * D + d0 * 16 + hi * 8) * 2));
    VSBAR();
    qkt<0>(pA0, pA1, K_lds, r32, hi, qr);
    VSBAR();
#define PX(t, TP, C0, C1, N0, N1, DO_NEXT) do { SBAR();     \
        { const int kb_ = (t) * KVBLK; if (kb_ + KVBLK - 1 > qlo) mask_tile(C0, C1, qm - kb_, 0x40000000u); }                                             \
        SBAR();                                                                                                                                        \
        if (DO_NEXT) qkt<1 - (TP)>(N0, N1, K_lds, r32, hi, qr);                                                                                        \
        partialSM_bf(C0, C1, m_reg, al); finishSM(C0, C1, al, l_reg, pa0, pa1, pa2, pa3);                                                              \
        _Pragma("unroll") for (int g_ = 0; g_ < 16; ++g_) { __builtin_amdgcn_sched_group_barrier(0x008, 1, 0); __builtin_amdgcn_sched_group_barrier(0x002, 16, 0); }     \
        SBAR();                                                                                                                                        \
        { bf16x8* pb_ = (bf16x8*)(P_w + (TP) * 4096) + lane; pb_[0] = pa0; pb_[64] = pa1; pb_[128] = pa2; pb_[192] = pa3; }                            \
        { const int any_ = __any(al < 1.f) ? 1 : 0; if (hi == 0) al_w[(TP) * 32 + r32] = al; if (lane == 0) { fl_w[TP] = (float)any_; fl_w[(TP) + 4] = (float)any_; } }                       \
        if ((t) + 1 == NT) { if (hi == 0) li_w[r32] = l_reg; }                                                                                         \
        SBAR(); VSBAR(); } while (0)
    for (int t = 0; t + 2 < NT; t += 2) { PX(t, 0, pA0, pA1, pB0, pB1, true); PX(t + 1, 1, pB0, pB1, pA0, pA1, true); }
    PX(NT - 2, 0, pA0, pA1, pB0, pB1, true); PX(NT - 1, 1, pB0, pB1, pA0, pA1, false);
#undef PX
#undef PLOADK
#undef PWRITEK
#undef PLOADV
#undef PWRITEV
}
template <int PB>
__device__ __forceinline__ void pv8(f32x16* ol, f32x16* oh, int vb0, bf16x8 pa0, bf16x8 pa1, bf16x8 pa2, bf16x8 pa3) {
#define TRRD(dst, off) asm volatile("ds_read_b64_tr_b16 %0, %1 offset:%2" : "=&v"(dst) : "v"(vb0), "i"(off) : "memory")
#define LGKW(n) do { asm volatile("s_waitcnt lgkmcnt(%0)" :: "i"(n) : "memory"); SBAR(); } while (0)
#define VB8(g) ((((g) < 4 ? PB : 2 + PB)) * SHM_V + v_rd_off((g) & 3, 0, 0))
#define VRD8(L, H, g) do { _Pragma("unroll") for (int i_ = 0; i_ < 4; ++i_) { TRRD(L[i_], VB8(g) + i_ * 4096); TRRD(H[i_], VB8(g) + i_ * 4096 + 2048); } } while (0)
#define PVM8(L, H, ACC) do { ACC = __builtin_amdgcn_mfma_f32_32x32x16_bf16(pa0, (bf16x8){L[0][0], L[0][1], L[0][2], L[0][3], H[0][0], H[0][1], H[0][2], H[0][3]}, ACC, 0, 0, 0); \
        ACC = __builtin_amdgcn_mfma_f32_32x32x16_bf16(pa1, (bf16x8){L[1][0], L[1][1], L[1][2], L[1][3], H[1][0], H[1][1], H[1][2], H[1][3]}, ACC, 0, 0, 0); \
        ACC = __builtin_amdgcn_mfma_f32_32x32x16_bf16(pa2, (bf16x8){L[2][0], L[2][1], L[2][2], L[2][3], H[2][0], H[2][1], H[2][2], H[2][3]}, ACC, 0, 0, 0); \
        ACC = __builtin_amdgcn_mfma_f32_32x32x16_bf16(pa3, (bf16x8){L[3][0], L[3][1], L[3][2], L[3][3], H[3][0], H[3][1], H[3][2], H[3][3]}, ACC, 0, 0, 0); SBAR(); } while (0)
    s16x4 la[4], ha[4], lb[4], hb[4];
    VRD8(la, ha, 0);
    VRD8(lb, hb, 1); LGKW(8); PVM8(la, ha, ol[0]);
    VRD8(la, ha, 2); LGKW(8); PVM8(lb, hb, ol[1]);
    VRD8(lb, hb, 3); LGKW(8); PVM8(la, ha, ol[2]);
    VRD8(la, ha, 4); LGKW(8); PVM8(lb, hb, ol[3]);
    VRD8(lb, hb, 5); LGKW(8); PVM8(la, ha, oh[0]);
    VRD8(la, ha, 6); LGKW(8); PVM8(lb, hb, oh[1]);
    VRD8(lb, hb, 7); LGKW(8); PVM8(la, ha, oh[2]);
    LGKW(0); PVM8(lb, hb, oh[3]);
#undef TRRD
#undef LGKW
#undef VB8
#undef VRD8
#undef PVM8
}
typedef __attribute__((address_space(3))) const bf16x8 lds_bf16x8_t;
typedef __attribute__((address_space(3))) const float lds_f32_t;
__device__ __forceinline__ void vs_store2(const f32x16& o0, const f32x16& o1, int lia, bf16_t* O, int rg, int r32, int hi, int coff) {
    constexpr int ldo = 2048;
    const unsigned obase = (unsigned)((rg * QBLK + 4 * hi) * ldo + r32 + coff);
#pragma unroll
    for (int r = 0; r < 16; ++r) { const int orow0 = (r & 3) + 8 * (r >> 2); const float rli = __builtin_amdgcn_rcpf(*(lds_f32_t*)(lia + crow(r, 0) * 4));
#pragma unroll
        for (int j = 0; j < 2; ++j) { const float v = (j ? o1[r] : o0[r]) * rli;
            const float vn = __builtin_bit_cast(float, __builtin_amdgcn_update_dpp(0, __builtin_bit_cast(int, v), 0xB1, 0xF, 0xF, true));
            if ((r32 & 1) == 0) *(unsigned*)(reinterpret_cast<char*>(O) + ((obase + (unsigned)(orow0 * ldo + j * 32)) * 2u)) = cvtpk(v, vn); } }
    SBAR();
}
template <int SEQ_>
__device__ __forceinline__ void vs_consumer(const BlockRefVS& cur, char* lds, int cw, int lane, int ct, int NT) {
    asm volatile("" : "+v"(lane), "+v"(ct));
    const int r32 = lane & 31, hi = lane >> 5;
    char* V_lds = lds; const char* P_all = lds + VS_P;
    int pbi = (int)(uintptr_t)P_all + lane * 16, smi = (int)(uintptr_t)(lds + VS_SMALL) + hi * 16;
    asm volatile("" : "+v"(pbi), "+v"(smi));
    const int vbw = (int)(uintptr_t)V_lds + v_rd_base(lane) + (cw >> 1) * (2 * SHM_V) + ((2 * cw) & 3) * 512;
    const bf16_t* Vl = cur.Vlo; const bf16_t* Vh = cur.Vlo + (size_t)SEQ_ * 128; const bf16_t* Kg = cur.K;
    f32x16 a00 = {}, a01 = {}, a10 = {}, a11 = {}, a20 = {}, a21 = {}, a30 = {}, a31 = {};
    asm volatile("" : "+v"(a00), "+v"(a01), "+v"(a10), "+v"(a11), "+v"(a20), "+v"(a21), "+v"(a30), "+v"(a31));
    unsigned rofm[4];
#pragma unroll
    for (int m = 0; m < 4; ++m) { const int kk = (m >> 1) * 8 + ((lane & 31) >> 2); const int k_ = ((kk & ~0xC) | ((kk & 4) << 1) | ((kk & 8) >> 1)) + 16 * cw;
        const int c_ = ((2 * m + (lane >> 5)) & 3) * 32 + (lane & 3) * 8; rofm[m] = (unsigned)((k_ * D + c_) * 2); }
    unsigned rofk[4];
#pragma unroll
    for (int m = 0; m < 4; ++m) { const int row_ = 16 * cw + 4 * m + (lane >> 4); rofk[m] = (unsigned)(row_ * 256 + (((lane & 15) * 16) ^ ((row_ & 7) << 4))); }
#define CDMAK(t, bf) do { const size_t to_ = (size_t)(t) * (KVBLK * D); _Pragma("unroll") for (int m_ = 0; m_ < 4; ++m_)                                  \
        __builtin_amdgcn_global_load_lds((const unsigned*)((const char*)(Kg + to_) + rofk[m_]), (PG8_LAS unsigned*)(lds + VS_K + (bf) * SHM_K + cw * 4096 + m_ * 1024), 16, 0, 0); } while (0)
#define CDMAV(t, bf) do { const size_t to_ = (size_t)(t) * (KVBLK * D); _Pragma("unroll") for (int m_ = 0; m_ < 4; ++m_) {                                \
        __builtin_amdgcn_global_load_lds((const unsigned*)((const char*)(Vl + to_) + rofm[m_]), (PG8_LAS unsigned*)(V_lds + (bf) * SHM_V + cw * 4096 + m_ * 1024), 16, 0, 0);          \
        __builtin_amdgcn_global_load_lds((const unsigned*)((const char*)(Vh + to_) + rofm[m_]), (PG8_LAS unsigned*)(V_lds + (2 + (bf)) * SHM_V + cw * 4096 + m_ * 1024), 16, 0, 0); } } while (0)
#define TRRD(dst, off) asm volatile("ds_read_b64_tr_b16 %0, %1 offset:%2" : "=&v"(dst) : "v"(vbw), "i"(off) : "memory")
#define VRDC(L, H, PB, j) do { _Pragma("unroll") for (int i_ = 0; i_ < 4; ++i_) { TRRD(L[i_], (PB) * SHM_V + (j) * 512 + i_ * 4096); TRRD(H[i_], (PB) * SHM_V + (j) * 512 + i_ * 4096 + 2048); } } while (0)
#define VFR(L, H, i) (bf16x8){L[i][0], L[i][1], L[i][2], L[i][3], H[i][0], H[i][1], H[i][2], H[i][3]}
#define PVMH(A0, A1, PA, h) do { _Pragma("unroll") for (int i_ = 0; i_ < 2; ++i_) { A0 = __builtin_amdgcn_mfma_f32_32x32x16_bf16(PA[i_], VFR(la, ha, 2 * (h) + i_), A0, 0, 0, 0); A1 = __builtin_amdgcn_mfma_f32_32x32x16_bf16(PA[i_], VFR(lb, hb, 2 * (h) + i_), A1, 0, 0, 0); } } while (0)
#define PLDH(PA, rg, PB, h) do { lds_bf16x8_t* pb_ = (lds_bf16x8_t*)(pbi + (rg) * 8192 + (PB) * 4096 + (h) * 2048); PA[0] = pb_[0]; PA[1] = pb_[64]; } while (0)
#define PVMC(A0, A1, rg, PB) do { PLDH(pA, rg, PB, 0); PVMH(A0, A1, pA, 0); SBAR(); PLDH(pA, rg, PB, 1); PVMH(A0, A1, pA, 1); } while (0)
#define PLD(PA, rg, PB) do { lds_bf16x8_t* pb_ = (lds_bf16x8_t*)(pbi + (rg) * 8192 + (PB) * 4096); PA[0] = pb_[0]; PA[1] = pb_[64]; PA[2] = pb_[128]; PA[3] = pb_[192]; } while (0)
#define RSC(A0, A1, rg, PB) do { if (f##rg##_ != 0.f) { asm volatile("" ::: "memory"); _Pragma("unroll") for (int r = 0; r < 16; ++r) { const float a_ = *(lds_f32_t*)(smi + ((rg) * 128 + (PB) * 32 + crow(r, 0)) * 4); A0[r] *= a_; A1[r] *= a_; } asm volatile("" ::: "memory"); } } while (0)
#define CPV(PB) do { s16x4 la[4], ha[4], lb[4], hb[4]; bf16x8 pA[2];                                                                                     \
        VRDC(la, ha, PB, 0); VRDC(lb, hb, PB, 1);                                                                                                        \
        const float f0_ = *(lds_f32_t*)(smi + (96 + (PB)) * 4), f1_ = *(lds_f32_t*)(smi + (128 + 96 + (PB)) * 4), f2_ = *(lds_f32_t*)(smi + (256 + 96 + (PB)) * 4), f3_ = *(lds_f32_t*)(smi + (384 + 96 + (PB)) * 4);     \
        asm volatile("s_waitcnt lgkmcnt(0)" ::: "memory"); SBAR();                                                                                     \
        RSC(a00, a01, 0, PB); SBAR(); PVMC(a00, a01, 0, PB); SBAR();                                                                                     \
        RSC(a10, a11, 1, PB); SBAR(); PVMC(a10, a11, 1, PB); SBAR();                                                                                     \
        RSC(a20, a21, 2, PB); SBAR(); PVMC(a20, a21, 2, PB); SBAR();                                                                                     \
        RSC(a30, a31, 3, PB); SBAR(); PVMC(a30, a31, 3, PB); SBAR(); } while (0)
    CDMAK(0, 0); CDMAK(1, 1); CDMAV(0, 0); VMW(); SBAR();
    VSBAR();
    VSBAR();
    if (2 < NT) CDMAK(2, 0);
    VMW(); SBAR(); VSBAR();
#pragma unroll 1
    for (int t = 1; ; t += 2) {
        CDMAV(t, 1); if (t + 2 < NT) CDMAK(t + 2, 1); SBAR(); CPV(0); VMW(); SBAR(); VSBAR();
        if (t + 1 < NT) { CDMAV(t + 1, 0); if (t + 3 < NT) CDMAK(t + 3, 0); SBAR(); }
        CPV(1);
        if (t + 1 >= NT) break;
        VMW(); SBAR(); VSBAR();
    }
#undef CDMAV
#undef CDMAK
#undef TRRD
#undef VRDC
#undef VFR
#undef PVMC
#undef PVMH
#undef PLDH
#undef PLD
#undef RSC
#undef CPV
    vs_store2(a00, a01, smi + 64 * 4, cur.O, 0, r32, hi, cw * 64);
    vs_store2(a10, a11, smi + (128 + 64) * 4, cur.O, 1, r32, hi, cw * 64);
    vs_store2(a20, a21, smi + (256 + 64) * 4, cur.O, 2, r32, hi, cw * 64);
    vs_store2(a30, a31, smi + (384 + 64) * 4, cur.O, 3, r32, hi, cw * 64);
}
template <int SEQ_>
__device__ __forceinline__ void attn_block_vs(const BlockRefVS& cur, char* lds, const int tid) {
    const int wid = __builtin_amdgcn_readfirstlane(tid >> 6), lane = tid & 63;
    const int NT = (cur.P0 + VS_QB - 1) / KVBLK + 1;
    if (wid < 4) vs_producer(cur, lds, wid, lane, tid, NT); else vs_consumer<SEQ_>(cur, lds, wid - 4, lane, tid - 256, NT);
    __syncthreads();
}
template <int SEQ_, class Get>
__device__ __forceinline__ void attn_stream_vs(int n, const Get& get, char* lds) {
    const int tid = threadIdx.x;
    for (int i = 0; i < n; ++i) { const BlockRefVS cur = get(i); attn_block_vs<SEQ_>(cur, lds, tid); }
}
#undef ROWB
#undef VMW
#undef VMWN
#undef SLOAD_H
#undef SWRITE_HK
#undef SWRITE_HV
#undef SWRITE_H
template <int MODE, class Get>
__device__ __forceinline__ void attn_stream(int n, const Get& get, int ldo, char* lds) {
    if (n <= 0) return;
    BlockRef cur = get(0); Seam S;
    int tid = threadIdx.x; asm volatile("" : "+v"(tid));
    attn_prime<MODE>(cur, lds, S, tid);
    for (int i = 0; i < n; ++i) {
        const BlockRef nxt = (i + 1 < n) ? get(i + 1) : cur;
        attn_block<MODE>(cur, nxt, ldo, lds, S, tid);
        cur = nxt;
    }
}
}

constexpr int NWAVES = 8;
constexpr int N_PHASES = 11;
#ifndef MK_N_LAUNCHES
#define MK_N_LAUNCHES 1
#endif
constexpr int N_LAUNCHES = MK_N_LAUNCHES;
static_assert(N_LAUNCHES == 1, "the phase program needs the in-kernel grid barrier");

constexpr size_t MiB = 1u << 20;
constexpr size_t WS_CTL = 0, CTL_ZERO_BYTES = 1 * MiB;
constexpr size_t WS_ROPEC = 1 * MiB, WS_ROPES = 5 * MiB;
constexpr size_t WS_WSB = 9 * MiB, WS_WDA = 25 * MiB, WS_WOUT = 41 * MiB, WS_WP = 73 * MiB;
constexpr size_t WS_SELI = 89 * MiB, WS_SELG = 97 * MiB;
constexpr size_t WS_XB = 112 * MiB;
constexpr size_t WS_WIN = 240 * MiB;
constexpr size_t WS_GATE = 400 * MiB;
constexpr size_t WS_QKV = 656 * MiB;
constexpr size_t WS_OSB = 1040 * MiB, WS_O1 = 1104 * MiB, WS_O2 = 1168 * MiB, WS_END = 1232 * MiB;
constexpr int P_ROWB = 3072;
constexpr int P_SLICEB = 384;
constexpr size_t WS_PD = 896 * MiB, WS_ST = 960 * MiB;
constexpr size_t WS_UQ = WS_QKV, WS_VQ = WS_QKV + 64 * MiB;
constexpr size_t WS_H1Q = WS_WIN + 128 * MiB;
constexpr size_t WS_US = 105 * MiB, WS_VS = WS_US + 65536, WS_HS = WS_VS + 65536;
constexpr size_t WS_SX = WS_HS + 65536, WS_SW = WS_SX + 65536;
constexpr size_t WS_CM = 512 * 1024;
constexpr size_t WS_OSBQ = 800 * MiB, WS_ODAQ = 832 * MiB;
constexpr size_t WS_SOSB = WS_SW + 131072, WS_SODA = WS_SOSB + 65536;
constexpr size_t WS_MQ = 864 * MiB;
constexpr size_t WS_RM = 640 * 1024;
constexpr size_t WS_WPQ = WS_WDA + 8 * MiB;
constexpr size_t WS_SWP = WS_SODA + 131072;
constexpr size_t WS_LNM = WS_SODA + 196608, WS_LNR = WS_LNM + 65536;
constexpr size_t WS_SM = WS_SODA + 65536;
constexpr size_t QKV_T = (size_t)T_TOK * 2048;
constexpr int CW_BAR = 4096;

constexpr int RING_OFF = 0, RING_BYTES = 131072;
constexpr int LDSCTL_OFF = RING_BYTES, MISC_OFF = LDSCTL_OFF + 320;
constexpr int LDS_BYTES = 147456;
static_assert(MISC_OFF + 128 <= LDS_BYTES && att::LDS_BYTES <= RING_BYTES, "LDS map");

#define GAS __attribute__((address_space(1)))
#define LAS __attribute__((address_space(3)))
typedef unsigned v4u __attribute__((ext_vector_type(4)));
typedef unsigned v2u __attribute__((ext_vector_type(2)));
typedef float f32x4 __attribute__((ext_vector_type(4)));
typedef GAS unsigned gu32;
#define RLX_AGENT __ATOMIC_RELAXED, __HIP_MEMORY_SCOPE_AGENT
#define LDS_WAIT() asm volatile("s_waitcnt lgkmcnt(0)" ::: "memory")
__device__ __forceinline__ unsigned f2bf(float f) { unsigned u = __builtin_bit_cast(unsigned, f); return (u + 0x7fffu + ((u >> 16) & 1u)) >> 16; }
__device__ __forceinline__ unsigned pk2(float lo, float hi) { return f2bf(lo) | (f2bf(hi) << 16); }
__device__ __forceinline__ float bflo(unsigned w) { return __uint_as_float(w << 16); }
__device__ __forceinline__ float bfhi(unsigned w) { return __uint_as_float(w & 0xffff0000u); }
__device__ __forceinline__ float wave_sum(float v) {
#pragma unroll
    for (int o = 1; o < 64; o <<= 1) v += __shfl_xor(v, o);
    return v;
}

#define XB_TMO      128
#define XB_XCNT(j)  (256  + 64 * (j))
#define XB_XSUB(j)  (1280 + 64 * (j))
#define XB_XGEN(j)  (2304 + 64 * (j))
#define XB_TOP      3328
#define XB_TOPGEN   3392
#define XCD_BAR_WORDS 3456
#define XB_SPIN_CAP (1u << 18)

__device__ __forceinline__ unsigned xb_ld(unsigned* p)              { return __hip_atomic_load(p, __ATOMIC_RELAXED, __HIP_MEMORY_SCOPE_AGENT); }
__device__ __forceinline__ unsigned xb_add(unsigned* p, unsigned v) { return __hip_atomic_fetch_add(p, v, __ATOMIC_RELAXED, __HIP_MEMORY_SCOPE_AGENT); }
__device__ __forceinline__ unsigned xb_xcc_id() { return (unsigned)__builtin_amdgcn_s_getreg((3 << 11) | 20) & 0xFu; }
#define XB_SPIN(cond, bar) do { unsigned _sp = 0; while (cond) { __builtin_amdgcn_s_sleep(1); \
    if ((++_sp & 255u) == 0u) { if (xb_ld(&(bar)[XB_TMO])) break; if (_sp > XB_SPIN_CAP) { atomicAdd(&(bar)[XB_TMO], 1u); break; } } } } while (0)

struct XcdBarrier {
    unsigned* bar; unsigned x;
    volatile LAS unsigned* st;
};

__device__ __forceinline__ XcdBarrier xcd_barrier_post(unsigned* bar, volatile LAS unsigned* st) {
    XcdBarrier b; b.bar = bar; b.x = xb_xcc_id(); b.st = st;
    if (threadIdx.x == 0) (void)xb_add(&bar[XB_XCNT(b.x)], 1u);
    return b;
}
__device__ __forceinline__ void xcd_barrier_complete(unsigned* bar, unsigned x, unsigned& nloc, unsigned& nx) {
    const unsigned G = gridDim.x * gridDim.y * gridDim.z;
    unsigned sum, cnt, mine, sp = 0u;
    for (;;) {
        sum = 0u; cnt = 0u; mine = 0u;
#pragma unroll
        for (unsigned j = 0; j < 16; ++j) { const unsigned c = xb_ld(&bar[XB_XCNT(j)]); sum += c; cnt += (c > 0u) ? 1u : 0u; mine = (j == x) ? c : mine; }
        if (sum == G) break;
        __builtin_amdgcn_s_sleep(1);
        if ((++sp & 255u) == 0u) { if (xb_ld(&bar[XB_TMO])) break; if (sp > XB_SPIN_CAP) { atomicAdd(&bar[XB_TMO], 1u); break; } }
    }
    nloc = mine > 0u ? mine : 1u; nx = cnt > 0u ? cnt : 1u;
}

__device__ __forceinline__ void xcd_barrier(const XcdBarrier& b) {
    asm volatile("s_waitcnt vmcnt(0)" ::: "memory");
    __syncthreads();
    if (threadIdx.x == 0) {
        unsigned* bar = b.bar;
        __builtin_amdgcn_s_waitcnt(0);
        unsigned nloc = b.st[0], nx = b.st[1];
        if (nloc == 0u) { xcd_barrier_complete(bar, b.x, nloc, nx); b.st[0] = nloc; b.st[1] = nx; }
        const unsigned old = xb_add(&bar[XB_XSUB(b.x)], 1u);
        const unsigned gen = old / nloc;
        if (old + 1u == (gen + 1u) * nloc) {
            __builtin_amdgcn_fence(__ATOMIC_RELEASE, "agent");
            asm volatile("s_waitcnt vmcnt(0)" ::: "memory");
            const unsigned og = xb_add(&bar[XB_TOP], 1u);
            const unsigned tg = og / nx;
            if (og + 1u == (tg + 1u) * nx) xb_add(&bar[XB_TOPGEN], 1u);
            else XB_SPIN(xb_ld(&bar[XB_TOPGEN]) == tg, bar);
            __builtin_amdgcn_fence(__ATOMIC_ACQUIRE, "agent");
            xb_add(&bar[XB_XGEN(b.x)], 1u);
            asm volatile("s_waitcnt vmcnt(0)" ::: "memory");
        } else {
            XB_SPIN(xb_ld(&bar[XB_XGEN(b.x)]) == gen, bar);
            __builtin_amdgcn_fence(__ATOMIC_ACQUIRE, "agent");
            asm volatile("s_waitcnt vmcnt(0)" ::: "memory");
        }
    }
    __syncthreads();
}
#define NTLOAD(p) __builtin_nontemporal_load(p)
struct Frame {
    LAS unsigned char* lds; int wave, vcu, G;
    float* out; unsigned char* ws;
};
__device__ __forceinline__ int win_src_col(int n) {
    if (n < 6144 || n >= 10240) return n;
    const int j = n & 127, g = j >> 3, e = j & 7;
    return (n & ~127) + (e < 4 ? 4 * g + e : 64 + 4 * g + (e - 4));
}
template <bool REMAP>
__device__ __forceinline__ void p0_transpose_item(const float* W, int K, int N, bf16_t* WT, LAS float* scr, int item, int lane) {
    const int nblk = N / 32, kb = item / nblk, nb = item % nblk, k0 = 64 * kb, n0 = 32 * nb;
    const int srcc = REMAP ? win_src_col(n0 + (lane & 31)) : n0 + (lane & 31);
#pragma unroll 8
    for (int i = 0; i < 32; ++i) { const int kk = 2 * i + (lane >> 5); scr[kk * 33 + (lane & 31)] = W[(size_t)(k0 + kk) * N + srcc]; }
    LDS_WAIT(); asm volatile("" ::: "memory");
    const int c = lane & 7;
#pragma unroll
    for (int j = 0; j < 4; ++j) { const int n = (lane >> 3) + 8 * j; const LAS float* s = scr + (8 * c) * 33 + n;
        v4u o; o.x = pk2(s[0 * 33], s[1 * 33]); o.y = pk2(s[2 * 33], s[3 * 33]); o.z = pk2(s[4 * 33], s[5 * 33]); o.w = pk2(s[6 * 33], s[7 * 33]);
        *(GAS v4u*)(WT + (size_t)(n0 + n) * K + k0 + 8 * c) = o; }
    LDS_WAIT(); asm volatile("" ::: "memory");
}
__device__ __forceinline__ void cvt_stream(const float* src, bf16_t* dst, size_t n8, int gw, int NGW, int lane) {
    for (size_t i = (size_t)gw * 64 + lane; i < n8; i += (size_t)NGW * 64) {
        const f32x4 a = ((const GAS f32x4*)src)[2 * i], b = ((const GAS f32x4*)src)[2 * i + 1];
        v4u o; o.x = pk2(a.x, a.y); o.y = pk2(a.z, a.w); o.z = pk2(b.x, b.y); o.w = pk2(b.z, b.w);
        ((GAS v4u*)dst)[i] = o;
    }
}
template <int KC, bool NTW>
__device__ __forceinline__ void col_amax(const float* W, int K, int N, unsigned* CM, int gw, int NGW) {
    const int n4 = N / 4;
    for (int idx = gw * 64 + ((int)threadIdx.x & 63); idx < n4 * (K / KC); idx += NGW * 64) {
        const int c4 = idx % n4, kp = idx / n4;
        const GAS f32x4* src = (const GAS f32x4*)(W + (size_t)(kp * KC) * N) + c4;
        f32x4 m = (f32x4){0.f, 0.f, 0.f, 0.f};
#pragma unroll 16
        for (int k = 0; k < KC; ++k) { const f32x4 t = NTW ? NTLOAD(src + (size_t)k * n4) : src[(size_t)k * n4]; m.x = fmaxf(m.x, fabsf(t.x)); m.y = fmaxf(m.y, fabsf(t.y)); m.z = fmaxf(m.z, fabsf(t.z)); m.w = fmaxf(m.w, fabsf(t.w)); }
        atomicMax(CM + 4 * c4, __float_as_uint(m.x)); atomicMax(CM + 4 * c4 + 1, __float_as_uint(m.y)); atomicMax(CM + 4 * c4 + 2, __float_as_uint(m.z)); atomicMax(CM + 4 * c4 + 3, __float_as_uint(m.w));
    }
}
__device__ __forceinline__ void p0_prologue(Frame& F, const float* x_, const int* pos_, const float* w_in_, const float* w_sb_, const float* w_da_, const float* w_out_, const float* w_q_, const float* keys_) {
    const int gw = F.vcu * NWAVES + F.wave, NGW = F.G * NWAVES;
    bf16_t* WPt = (bf16_t*)(F.ws + WS_WP);
    {
        typedef float f32x16_ __attribute__((ext_vector_type(16)));
        const int lane = (int)threadIdx.x & 63, r = lane & 31, h = lane >> 5;
        for (int task = gw; task < 16 * 128; task += NGW) {
            const int hc = task >> 7, j0 = (task & 127) * 32;
            pg8::bf16x8 af[8];
            { const GAS f32x4* wp = (const GAS f32x4*)(w_q_ + (size_t)(j0 + r) * 2048 + hc * 128 + 8 * h);
#pragma unroll
              for (int s_ = 0; s_ < 8; ++s_) { const f32x4 a = wp[4 * s_], b = wp[4 * s_ + 1];
                  af[s_] = __builtin_bit_cast(pg8::bf16x8, (v4u){pg8::cvt_pk_bf16(a.x, a.y), pg8::cvt_pk_bf16(a.z, a.w), pg8::cvt_pk_bf16(b.x, b.y), pg8::cvt_pk_bf16(b.z, b.w)}); } }
#pragma unroll 1
            for (int kt = 0; kt < 4; ++kt) {
                const GAS f32x4* kp = (const GAS f32x4*)(keys_ + (size_t)hc * 16384 + (size_t)(32 * kt + r) * 128 + 8 * h);
                f32x16_ acc;
#pragma unroll
                for (int i = 0; i < 16; ++i) acc[i] = 0.f;
#pragma unroll
                for (int s_ = 0; s_ < 8; ++s_) { const f32x4 a = kp[4 * s_], b = kp[4 * s_ + 1];
                    const pg8::bf16x8 bfr = __builtin_bit_cast(pg8::bf16x8, (v4u){pg8::cvt_pk_bf16(a.x, a.y), pg8::cvt_pk_bf16(a.z, a.w), pg8::cvt_pk_bf16(b.x, b.y), pg8::cvt_pk_bf16(b.z, b.w)});
                    acc = __builtin_amdgcn_mfma_f32_32x32x16_bf16(af[s_], bfr, acc, 0, 0, 0); }
#pragma unroll
                for (int q = 0; q < 4; ++q) { v2u o; o.x = pk2(acc[4 * q], acc[4 * q + 1]); o.y = pk2(acc[4 * q + 2], acc[4 * q + 3]);
                    *(GAS v2u*)(WPt + (size_t)(hc * 128 + 32 * kt + r) * DM + j0 + 8 * q + 4 * h) = o; }
            }
        }
    }
    {
        const int lane = (int)threadIdx.x & 63; unsigned* XQ = (unsigned*)(F.ws + WS_XB); float* SX = (float*)(F.ws + WS_SX);
        for (int row = gw; row < T_TOK; row += NGW) {
            const GAS f32x4* src = (const GAS f32x4*)(x_ + (size_t)row * DM) + lane;
            f32x4 v[16]; float am = 0.f;
#pragma unroll
            for (int j = 0; j < 16; ++j) { v[j] = NTLOAD(src + 64 * j); am = fmaxf(am, fmaxf(fmaxf(fabsf(v[j].x), fabsf(v[j].y)), fmaxf(fabsf(v[j].z), fabsf(v[j].w)))); }
#pragma unroll
            for (int o = 1; o < 64; o <<= 1) am = fmaxf(am, __shfl_xor(am, o));
            if (am < 1e-30f) am = 1e-30f;
            const float inv = 127.f / am; if (lane == 0) SX[row] = am * (1.f / 127.f);
#pragma unroll
            for (int j = 0; j < 16; ++j) { const int a = (int)rintf(v[j].x * inv), b = (int)rintf(v[j].y * inv), c = (int)rintf(v[j].z * inv), d = (int)rintf(v[j].w * inv);
                ((GAS unsigned*)(XQ + (size_t)row * (DM / 4)))[64 * j + lane] = (unsigned)(a & 255) | ((unsigned)(b & 255) << 8) | ((unsigned)(c & 255) << 16) | ((unsigned)(d & 255) << 24); }
        }
    }
    col_amax<64, true>(w_in_, DM, IN_W, (unsigned*)(F.ws + WS_CM), gw, NGW);
    col_amax<16, false>(w_sb_, 2048, DM, (unsigned*)(F.ws + WS_CM) + IN_W, gw, NGW);
    col_amax<16, false>(w_da_, 2048, DM, (unsigned*)(F.ws + WS_CM) + IN_W + DM, gw, NGW);
    col_amax<32, false>(w_out_, DM, DM, (unsigned*)(F.ws + WS_CM) + IN_W + 2 * DM, gw, NGW);
    {
        float* rc = (float*)(F.ws + WS_ROPEC); float* rs = (float*)(F.ws + WS_ROPES);
        for (int idx = gw * 64 + ((int)threadIdx.x & 63); idx < T_TOK * 64; idx += NGW * 64) {
            const int t = idx >> 6, i = idx & 63;
            const float inv = powf(10000.0f, -((float)(2 * i) / 128.0f));
            const float ang = (float)pos_[t] * inv;
            float sn, cs; sincosf(ang, &sn, &cs);
            rc[idx] = cs; rs[idx] = sn;
        }
    }
}
template <bool REMAP>
__device__ __forceinline__ void transpose_q8(Frame& F, const float* W, int K, int N, unsigned char* WQ, const float* CMf, float* SW) {
    const int gw = F.vcu * NWAVES + F.wave, NGW = F.G * NWAVES, lane = (int)threadIdx.x & 63;
    LAS float* scr = (LAS float*)(F.lds + RING_OFF + F.wave * 16384);
    const int nblk = N / 32;
    for (int item = gw; item < (K / 64) * nblk; item += NGW) {
        const int kb = item / nblk, nb = item % nblk, k0 = 64 * kb, n0 = 32 * nb;
        const int srcc = REMAP ? win_src_col(n0 + 4 * (lane & 7)) : n0 + 4 * (lane & 7);
        f32x4 ld[8];
#pragma unroll
        for (int i = 0; i < 8; ++i) ld[i] = NTLOAD((const GAS f32x4*)(W + (size_t)(k0 + 8 * i + (lane >> 3)) * N + srcc));
#pragma unroll
        for (int i = 0; i < 8; ++i) { LAS float* d = scr + (8 * i + (lane >> 3)) * 33 + 4 * (lane & 7); d[0] = ld[i].x; d[1] = ld[i].y; d[2] = ld[i].z; d[3] = ld[i].w; }
        LDS_WAIT(); asm volatile("" ::: "memory");
        const int c = lane & 7;
#pragma unroll
        for (int j = 0; j < 4; ++j) { const int n = (lane >> 3) + 8 * j; const LAS float* sp = scr + (8 * c) * 33 + n;
            float am = CMf[REMAP ? win_src_col(n0 + n) : n0 + n]; if (am < 1e-30f) am = 1e-30f; const float inv = 127.f / am;
            if (kb == 0 && c == 0) SW[n0 + n] = am * (1.f / 127.f);
            int q[8];
#pragma unroll
            for (int e = 0; e < 8; ++e) q[e] = (int)rintf(sp[e * 33] * inv) & 255;
            v2u o; o.x = (unsigned)q[0] | ((unsigned)q[1] << 8) | ((unsigned)q[2] << 16) | ((unsigned)q[3] << 24); o.y = (unsigned)q[4] | ((unsigned)q[5] << 8) | ((unsigned)q[6] << 16) | ((unsigned)q[7] << 24);
            *(GAS v2u*)(WQ + (size_t)(n0 + n) * K + k0 + 8 * c) = o; }
        LDS_WAIT(); asm volatile("" ::: "memory");
    }
}
__device__ __forceinline__ void p0b_weights(Frame& F, const float* w_in_, const float* w_sb_, const float* w_da_, const float* w_out_) {
    const float* CMf = (const float*)(F.ws + WS_CM); float* SW = (float*)(F.ws + WS_SW);
    transpose_q8<true>(F, w_in_, DM, IN_W, F.ws + WS_WIN, CMf, SW);
    transpose_q8<false>(F, w_sb_, 2048, DM, F.ws + WS_WSB, CMf + IN_W, SW + IN_W);
    transpose_q8<false>(F, w_da_, 2048, DM, F.ws + WS_WDA, CMf + IN_W + DM, SW + IN_W + DM);
    transpose_q8<false>(F, w_out_, DM, DM, F.ws + WS_WOUT, CMf + IN_W + 2 * DM, SW + IN_W + 2 * DM);
    {
        const int gw = F.vcu * NWAVES + F.wave, NGW = F.G * NWAVES, lane = (int)threadIdx.x & 63;
        const bf16_t* WPb = (const bf16_t*)(F.ws + WS_WP); unsigned* WPQ = (unsigned*)(F.ws + WS_WPQ); float* SWP = (float*)(F.ws + WS_SWP);
        for (int row = gw; row < 2048; row += NGW) {
            v4u w[8]; float am = 0.f;
#pragma unroll
            for (int i = 0; i < 8; ++i) { w[i] = ((const GAS v4u*)(WPb + (size_t)row * DM))[64 * i + lane];
                const unsigned q_[4] = {w[i].x, w[i].y, w[i].z, w[i].w};
#pragma unroll
                for (int e = 0; e < 4; ++e) am = fmaxf(am, fmaxf(fabsf(bflo(q_[e])), fabsf(bfhi(q_[e])))); }
#pragma unroll
            for (int o = 1; o < 64; o <<= 1) am = fmaxf(am, __shfl_xor(am, o));
            if (am < 1e-30f) am = 1e-30f;
            const float inv = 127.f / am; if (lane == 0) SWP[row] = am * (1.f / 127.f);
#pragma unroll
            for (int i = 0; i < 8; ++i) { const unsigned q_[4] = {w[i].x, w[i].y, w[i].z, w[i].w}; v2u o;
#pragma unroll
                for (int h = 0; h < 2; ++h) { const int a = (int)rintf(bflo(q_[2 * h]) * inv) & 255, b = (int)rintf(bfhi(q_[2 * h]) * inv) & 255, c = (int)rintf(bflo(q_[2 * h + 1]) * inv) & 255, d = (int)rintf(bfhi(q_[2 * h + 1]) * inv) & 255;
                    const unsigned pk = (unsigned)a | ((unsigned)b << 8) | ((unsigned)c << 16) | ((unsigned)d << 24); if (h == 0) o.x = pk; else o.y = pk; }
                ((GAS v2u*)(WPQ + (size_t)row * (DM / 4)))[64 * i + lane] = o; }
        }
    }
}
__device__ __forceinline__ void p3_combine(Frame& F, const float* lq1, const float* lk1, const float* lq2, const float* lk2, const float* subln_g, const float* pu_, const float* pv_) {
    const int gw = F.vcu * NWAVES + F.wave, NGW = F.G * NWAVES, lane = ((int)threadIdx.x & 63);
    float d1 = lq1[lane] * lk1[lane] + lq1[lane + 64] * lk1[lane + 64];
    float d2 = lq2[lane] * lk2[lane] + lq2[lane + 64] * lk2[lane + 64];
    d1 = wave_sum(d1); d2 = wave_sum(d2);
    const float lam = expf(d1) - expf(d2) + LAM_INIT;
    const f32x4 g4 = *(const f32x4*)(subln_g + 4 * lane);
    const bf16_t* O1 = (const bf16_t*)(F.ws + WS_O1); const bf16_t* O2 = (const bf16_t*)(F.ws + WS_O2);
    unsigned* OSBQ = (unsigned*)(F.ws + WS_OSBQ); unsigned* ODAQ = (unsigned*)(F.ws + WS_ODAQ); float* SOSB = (float*)(F.ws + WS_SOSB); float* SODA = (float*)(F.ws + WS_SODA);
    const bf16_t* OSB = (const bf16_t*)(F.ws + WS_OSB);
    for (int tok = gw; tok < T_TOK; tok += NGW) {
        float od[DA_HEADS][4]; float am = 0.f;
#pragma unroll
        for (int h = 0; h < DA_HEADS; ++h) {
            const size_t off = (size_t)tok * 2048 + h * 256 + 4 * lane;
            const v2u a = NTLOAD((const GAS v2u*)(O1 + off)), b = NTLOAD((const GAS v2u*)(O2 + off));
            const float v0 = bflo(a.x) - lam * bflo(b.x), v1 = bfhi(a.x) - lam * bfhi(b.x), v2 = bflo(a.y) - lam * bflo(b.y), v3 = bfhi(a.y) - lam * bfhi(b.y);
            const float ss = wave_sum((v0 * v0 + v1 * v1) + (v2 * v2 + v3 * v3));
            const float r = (1.0f - LAM_INIT) / sqrtf(ss * (1.0f / 256.0f) + LN_EPS);
            od[h][0] = v0 * r * g4.x; od[h][1] = v1 * r * g4.y; od[h][2] = v2 * r * g4.z; od[h][3] = v3 * r * g4.w;
            am = fmaxf(am, fmaxf(fmaxf(fabsf(od[h][0]), fabsf(od[h][1])), fmaxf(fabsf(od[h][2]), fabsf(od[h][3]))));
        }
#pragma unroll
        for (int o = 1; o < 64; o <<= 1) am = fmaxf(am, __shfl_xor(am, o));
        if (am < 1e-30f) am = 1e-30f;
        { const float inv = 127.f / am; if (lane == 0) SODA[tok] = am * (1.f / 127.f);
#pragma unroll
          for (int h = 0; h < DA_HEADS; ++h) { const int a = (int)rintf(od[h][0] * inv), b = (int)rintf(od[h][1] * inv), c = (int)rintf(od[h][2] * inv), d = (int)rintf(od[h][3] * inv);
              ((GAS unsigned*)(ODAQ + (size_t)tok * 512))[64 * h + lane] = (unsigned)(a & 255) | ((unsigned)(b & 255) << 8) | ((unsigned)(c & 255) << 16) | ((unsigned)(d & 255) << 24); } }
        v2u sb[8]; float am2 = 0.f;
#pragma unroll
        for (int i = 0; i < 8; ++i) { sb[i] = NTLOAD((const GAS v2u*)(OSB + (size_t)tok * 2048) + 64 * i + lane);
            am2 = fmaxf(am2, fmaxf(fmaxf(fabsf(bflo(sb[i].x)), fabsf(bfhi(sb[i].x))), fmaxf(fabsf(bflo(sb[i].y)), fabsf(bfhi(sb[i].y))))); }
#pragma unroll
        for (int o = 1; o < 64; o <<= 1) am2 = fmaxf(am2, __shfl_xor(am2, o));
        if (am2 < 1e-30f) am2 = 1e-30f;
        { const float inv = 127.f / am2; if (lane == 0) SOSB[tok] = am2 * (1.f / 127.f);
#pragma unroll
          for (int i = 0; i < 8; ++i) { const int a = (int)rintf(bflo(sb[i].x) * inv), b = (int)rintf(bfhi(sb[i].x) * inv), c = (int)rintf(bflo(sb[i].y) * inv), d = (int)rintf(bfhi(sb[i].y) * inv);
              ((GAS unsigned*)(OSBQ + (size_t)tok * 512))[64 * i + lane] = (unsigned)(a & 255) | ((unsigned)(b & 255) << 8) | ((unsigned)(c & 255) << 16) | ((unsigned)(d & 255) << 24); } }
    }
    {
        typedef float v16f_ __attribute__((ext_vector_type(16))); typedef int v6i_ __attribute__((ext_vector_type(6)));
        float* US = (float*)(F.ws + WS_US); float* VS = (float*)(F.ws + WS_VS);
        for (int r = gw; r < 2 * P_EXP; r += NGW) {
            const bool isv = r >= P_EXP; const int e = isv ? r - P_EXP : r;
            const GAS f32x4* src = (const GAS f32x4*)((isv ? pv_ : pu_) + (size_t)e * DM) + lane;
            f32x4 v[16]; float am = 0.f;
#pragma unroll
            for (int j = 0; j < 16; ++j) { v[j] = NTLOAD(src + 64 * j); am = fmaxf(am, fmaxf(fmaxf(fabsf(v[j].x), fabsf(v[j].y)), fmaxf(fabsf(v[j].z), fabsf(v[j].w)))); }
#pragma unroll
            for (int o = 1; o < 64; o <<= 1) am = fmaxf(am, __shfl_xor(am, o));
            if (am < 1e-30f) am = 1e-30f;
            const float inv = 7.5f / am; if (lane == 0) (isv ? VS : US)[e] = am * (1.f / 7.5f);
            v16f_ x0, y0, x1, y1;
#pragma unroll
            for (int i = 0; i < 16; ++i) { x0[i] = v[i >> 1][2 * (i & 1)] * inv; y0[i] = v[i >> 1][2 * (i & 1) + 1] * inv; x1[i] = v[8 + (i >> 1)][2 * (i & 1)] * inv; y1[i] = v[8 + (i >> 1)][2 * (i & 1) + 1] * inv; }
            const v6i_ p0 = __builtin_amdgcn_cvt_scalef32_2xpk16_fp6_f32(x0, y0, 1.0f), p1 = __builtin_amdgcn_cvt_scalef32_2xpk16_fp6_f32(x1, y1, 1.0f);
            GAS unsigned char* dst = (GAS unsigned char*)(F.ws + (isv ? WS_VQ : WS_UQ) + ((size_t)(lane >> 3) * P_EXP + e) * P_SLICEB);
            ((GAS v4u*)dst)[2 * (lane & 7)] = (v4u){(unsigned)p0[0], (unsigned)p0[1], (unsigned)p0[2], (unsigned)p0[3]};
            ((GAS v4u*)dst)[2 * (lane & 7) + 1] = (v4u){(unsigned)p1[0], (unsigned)p1[1], (unsigned)p1[2], (unsigned)p1[3]};
            ((GAS v4u*)(dst + 256))[lane & 7] = (v4u){(unsigned)p0[4], (unsigned)p0[5], (unsigned)p1[4], (unsigned)p1[5]};
        }
    }
}
__device__ __forceinline__ void p5b_quant(Frame& F) {
    const int gw = F.vcu * NWAVES + F.wave, NGW = F.G * NWAVES, lane = ((int)threadIdx.x & 63);
    const bf16_t* MB = (const bf16_t*)(F.ws + WS_XB); unsigned* MQ = (unsigned*)(F.ws + WS_MQ); const float* RM = (const float*)(F.ws + WS_RM); float* SM = (float*)(F.ws + WS_SM);
    for (int row = gw; row < T_TOK; row += NGW) {
        float am = RM[row]; if (am < 1e-30f) am = 1e-30f;
        const float inv = 127.f / am; if (lane == 0) SM[row] = am * (1.f / 127.f);
#pragma unroll
        for (int i = 0; i < 8; ++i) { const v4u w = NTLOAD((const GAS v4u*)(MB + (size_t)row * DM) + 64 * i + lane);
            const unsigned ws_[4] = {w.x, w.y, w.z, w.w}; v2u o;
#pragma unroll
            for (int h = 0; h < 2; ++h) { int q[4];
#pragma unroll
                for (int e = 0; e < 2; ++e) { const int a = (int)rintf(bflo(ws_[2 * h + e]) * inv), b = (int)rintf(bfhi(ws_[2 * h + e]) * inv);
                    q[2 * e] = (a < -127 ? -127 : (a > 127 ? 127 : a)) & 255; q[2 * e + 1] = (b < -127 ? -127 : (b > 127 ? 127 : b)) & 255; }
                const unsigned pk = (unsigned)q[0] | ((unsigned)q[1] << 8) | ((unsigned)q[2] << 16) | ((unsigned)q[3] << 24); if (h == 0) o.x = pk; else o.y = pk; }
            ((GAS v2u*)(MQ + (size_t)row * (DM / 4)))[64 * i + lane] = o; }
    }
}
__device__ __forceinline__ void p7_ln1(Frame& F, const float* ln1_g, const float* ln1_b) {
    const int gw = F.vcu * NWAVES + F.wave, NGW = F.G * NWAVES, lane = ((int)threadIdx.x & 63);
    unsigned* H1Q = (unsigned*)(F.ws + WS_H1Q); float* HS = (float*)(F.ws + WS_HS); float* LNM = (float*)(F.ws + WS_LNM); float* LNR = (float*)(F.ws + WS_LNR);
    for (int row = gw; row < T_TOK; row += NGW) {
        const GAS f32x4* yr = (GAS f32x4*)(F.out + (size_t)row * DM) + lane;
        f32x4 v[16]; float s = 0.f;
#pragma unroll
        for (int j = 0; j < 16; ++j) { v[j] = NTLOAD(yr + 64 * j); s += (v[j].x + v[j].y) + (v[j].z + v[j].w); }
        const float mean = wave_sum(s) * (1.f / DM); float s2 = 0.f;
#pragma unroll
        for (int j = 0; j < 16; ++j) { v[j] = v[j] - mean; s2 += (v[j].x * v[j].x + v[j].y * v[j].y) + (v[j].z * v[j].z + v[j].w * v[j].w); }
        const float rstd = 1.f / sqrtf(wave_sum(s2) * (1.f / DM) + LN_EPS);
        if (lane == 0) { LNM[row] = mean; LNR[row] = rstd; }
        float am = 0.f;
        const float* g1p = ln1_g; const float* b1p = ln1_b; asm volatile("" : "+s"(g1p), "+s"(b1p));
#pragma unroll
        for (int j = 0; j < 16; ++j) {
            const f32x4 g = ((const f32x4*)g1p)[64 * j + lane], b = ((const f32x4*)b1p)[64 * j + lane];
            const f32x4 o = v[j] * rstd * g + b;
            v[j] = o;
            am = fmaxf(am, fmaxf(fmaxf(fabsf(o.x), fabsf(o.y)), fmaxf(fabsf(o.z), fabsf(o.w))));
        }
#pragma unroll
        for (int o = 1; o < 64; o <<= 1) am = fmaxf(am, __shfl_xor(am, o));
        if (am < 1e-30f) am = 1e-30f;
        const float inv = 127.f / am; if (lane == 0) HS[row] = am * (1.f / 127.f);
#pragma unroll
        for (int j = 0; j < 16; ++j) { const int a = (int)rintf(v[j].x * inv), b = (int)rintf(v[j].y * inv), c = (int)rintf(v[j].z * inv), d = (int)rintf(v[j].w * inv);
            ((GAS unsigned*)(H1Q + (size_t)row * (DM / 4)))[64 * j + lane] = (unsigned)(a & 255) | ((unsigned)(b & 255) << 8) | ((unsigned)(c & 255) << 16) | ((unsigned)(d & 255) << 24); }
    }
}
__device__ __forceinline__ int med3i(int a, int b, int c) { int r; asm("v_med3_i32 %0, %1, %2, %3" : "=v"(r) : "v"(a), "v"(b), "v"(c)); return r; }
__device__ __forceinline__ int skey(float x) { const int b = __float_as_int(x); return b >= 0 ? b : (b ^ 0x7fffffff); }
#define INS16(T, key) do { const int k__ = (key); _Pragma("unroll") for (int i_ = 15; i_ >= 1; --i_) T[i_] = med3i(T[i_ - 1], T[i_], k__); T[0] = T[0] > k__ ? T[0] : k__; } while (0)
__device__ __forceinline__ void p9_topk(Frame& F) {
    const int gw = F.vcu * NWAVES + F.wave, NGW = F.G * NWAVES, lane = ((int)threadIdx.x & 63);
    const float* SC = (const float*)(F.ws + WS_XB); int* SELI = (int*)(F.ws + WS_SELI); float* SELG = (float*)(F.ws + WS_SELG);
    LAS float* buf = (LAS float*)(F.lds + RING_OFF + F.wave * 9216);
    for (int task = gw; task < T_TOK / 4; task += NGW) {
        const float* blk = SC + (size_t)task * 4 * 2048;
        int t[16];
#pragma unroll
        for (int i = 0; i < 16; ++i) t[i] = (int)0x80000000;
        for (int c = 0; c < 4; ++c) {
            f32x4 st[8];
#pragma unroll
            for (int i = 0; i < 8; ++i) st[i] = *(const GAS f32x4*)(blk + (size_t)((lane >> 3) + 8 * i) * 128 + c * 32 + (lane & 7) * 4);
            LDS_WAIT();
#pragma unroll
            for (int i = 0; i < 8; ++i) *(LAS f32x4*)(buf + ((lane >> 3) + 8 * i) * 36 + (lane & 7) * 4) = st[i];
            LDS_WAIT();
#pragma unroll
            for (int k8 = 0; k8 < 8; ++k8) { const f32x4 x = *(const LAS f32x4*)(buf + lane * 36 + k8 * 4);
#pragma unroll
                for (int e = 0; e < 4; ++e) { const int k = c * 32 + k8 * 4 + e; INS16(t, (skey(x[e]) & ~127) | (127 - k)); } }
        }
        const int tok = task * 4 + (lane >> 4), hc = lane & 15;
        const float* myrow = SC + (size_t)tok * 2048 + hc * 128;
        float va[16], vb[16]; int ia[16], ib[16];
#pragma unroll
        for (int i = 0; i < 16; ++i) { ia[i] = 127 - (t[i] & 127); va[i] = myrow[ia[i]]; }
#pragma unroll
        for (int i = 0; i < 16; ++i) { vb[i] = __shfl_down(va[i], 1); ib[i] = __shfl_down(ia[i], 1); }
        LDS_WAIT();
        if ((lane & 1) == 0) {
            int r[16];
#pragma unroll
            for (int i = 0; i < 16; ++i) r[i] = (int)0x80000000;
#pragma unroll
            for (int a = 0; a < 16; ++a)
#pragma unroll
                for (int b = 0; b < 16; ++b) if ((a + 1) * (b + 1) <= 16) INS16(r, (skey(va[a] + vb[b]) & ~255) | (255 - (a * 16 + b)));
            LAS float* my = buf + (lane >> 1) * 65; LAS int* myi = (LAS int*)my;
#pragma unroll
            for (int i = 0; i < 16; ++i) { my[i] = va[i]; my[16 + i] = vb[i]; myi[32 + i] = ia[i]; myi[48 + i] = ib[i]; }
            LDS_WAIT();
            float best[16]; int ex[16]; float m = -3.0e38f;
#pragma unroll
            for (int i = 0; i < 16; ++i) { const int pos = 255 - (r[i] & 255), a = pos >> 4, b = pos & 15; best[i] = my[a] + my[16 + b]; ex[i] = myi[32 + a] * P_KEYS + myi[48 + b]; m = fmaxf(m, best[i]); }
            float den = 0.f;
#pragma unroll
            for (int i = 0; i < 16; ++i) { best[i] = expf(best[i] - m); den += best[i]; }
            const float rden = 1.f / den;
            GAS v4u* oi = (GAS v4u*)(SELI + (size_t)tok * P_SEL + (hc >> 1) * 16); GAS f32x4* og = (GAS f32x4*)(SELG + (size_t)tok * P_SEL + (hc >> 1) * 16);
#pragma unroll
            for (int i = 0; i < 4; ++i) { oi[i] = (v4u){(unsigned)ex[4 * i], (unsigned)ex[4 * i + 1], (unsigned)ex[4 * i + 2], (unsigned)ex[4 * i + 3]};
                og[i] = (f32x4){best[4 * i] * rden, best[4 * i + 1] * rden, best[4 * i + 2] * rden, best[4 * i + 3] * rden}; }
        }
        LDS_WAIT();
    }
}
typedef float v32f_t __attribute__((ext_vector_type(32)));
typedef __bf16 v32bf_t __attribute__((ext_vector_type(32)));
typedef __bf16 bf2_t __attribute__((ext_vector_type(2)));
typedef __bf16 bf4_t __attribute__((ext_vector_type(4)));
typedef float f32x2_t __attribute__((ext_vector_type(2)));
typedef int v6i_t __attribute__((ext_vector_type(6)));

__device__ __forceinline__ float row16_sum(float v) {
    v += __builtin_bit_cast(float, __builtin_amdgcn_update_dpp(0, __builtin_bit_cast(int, v), 0xB1, 0xF, 0xF, true));
    v += __builtin_bit_cast(float, __builtin_amdgcn_update_dpp(0, __builtin_bit_cast(int, v), 0x4E, 0xF, 0xF, true));
    v += __builtin_bit_cast(float, __builtin_amdgcn_update_dpp(0, __builtin_bit_cast(int, v), 0x141, 0xF, 0xF, true));
    v += __builtin_bit_cast(float, __builtin_amdgcn_update_dpp(0, __builtin_bit_cast(int, v), 0x140, 0xF, 0xF, true));
    return v;
}
#define P10S_LOAD8(RA, RB, TAB, I0) do { const v4u ia_ = *(const LAS v4u*)(idb + s * 128 + (I0)), ib_ = *(const LAS v4u*)(idb + s * 128 + (I0) + 4); \
        const unsigned ie_[8] = {ia_.x, ia_.y, ia_.z, ia_.w, ib_.x, ib_.y, ib_.z, ib_.w}; \
        _Pragma("unroll") for (int j_ = 0; j_ < 8; ++j_) { const GAS unsigned char* p_ = (TAB) + (size_t)ie_[j_] * P_SLICEB; RA[j_] = *(const GAS v4u*)p_; RB[j_] = *(const GAS v2u*)(p_ + 256 - 8 * g); } \
        __builtin_amdgcn_sched_barrier(0); } while (0)
__device__ __forceinline__ void p10a_dots(Frame& F, const float* ln1_g, const float* ln1_b) {
    int tid_ = (int)threadIdx.x; asm volatile("" : "+v"(tid_));
    const int lane = tid_ & 63, s = lane >> 4, g = lane & 15, lp = g >> 1, k = g & 1;
    const int x = (int)blockIdx.x & 7, wgi = ((int)blockIdx.x >> 3) * NWAVES + F.wave, NWX = ((F.G - x + 7) >> 3) * NWAVES;
    LAS int* idb = (LAS int*)(F.lds + RING_OFF + F.wave * 4096); LAS float* zb = (LAS float*)(idb + 512);
    const int* SELI = (const int*)(F.ws + WS_SELI); float* PD = (float*)(F.ws + WS_PD) + (size_t)x * T_TOK * P_SEL;
    const GAS unsigned char* UQx = (const GAS unsigned char*)(F.ws + WS_UQ + (size_t)x * P_EXP * P_SLICEB + 16 * g);
#pragma unroll 1
    for (int t4 = wgi; t4 < T_TOK / 4; t4 += NWX) {
        const int t0 = 4 * t4;
        { const GAS v4u* sp = (const GAS v4u*)(SELI + (size_t)t0 * P_SEL); const v4u a = sp[lane], b = sp[64 + lane]; ((LAS v4u*)idb)[lane] = a; ((LAS v4u*)idb)[64 + lane] = b; }
        v2u hb[8];
        { const GAS f32x4* hp = (const GAS f32x4*)(F.out + (size_t)(t0 + s) * DM + 32 * x + 4 * lp) + 64 * 8 * k;
          const f32x4* g1 = (const f32x4*)ln1_g + 64 * 8 * k + 8 * x + lp; const f32x4* b1 = (const f32x4*)ln1_b + 64 * 8 * k + 8 * x + lp;
          asm volatile("" : "+v"(g1), "+v"(b1));
          const float m1 = ((const float*)(F.ws + WS_LNM))[t0 + s], r1 = ((const float*)(F.ws + WS_LNR))[t0 + s];
#pragma unroll
          for (int jj = 0; jj < 8; ++jj) { const f32x4 h = (hp[64 * jj] - m1) * r1 * g1[64 * jj] + b1[64 * jj]; hb[jj].x = pg8::cvt_pk_bf16(h.x, h.y); hb[jj].y = pg8::cvt_pk_bf16(h.z, h.w); } }
        LDS_WAIT();
#define P10_D2(dst, i) dst = __builtin_amdgcn_fdot2_f32_bf16(__builtin_shufflevector(__builtin_bit_cast(bf4_t, hb[(i) >> 1]), __builtin_bit_cast(bf4_t, hb[(i) >> 1]), 2 * ((i) & 1), 2 * ((i) & 1) + 1), \
                                                         __builtin_shufflevector(rb_, rb_, 2 * (i), 2 * (i) + 1), dst, false)
#define P10S_DOT8(RA, RB, I0) do { float d_[8]; _Pragma("unroll") for (int j_ = 0; j_ < 8; ++j_) { asm volatile("" : "+v"(RA[j_]), "+v"(RB[j_])); \
            const v32bf_t rb_ = __builtin_amdgcn_cvt_scalef32_pk32_bf16_fp6((v6i_t){(int)RA[j_].x, (int)RA[j_].y, (int)RA[j_].z, (int)RA[j_].w, (int)RB[j_].x, (int)RB[j_].y}, 1.0f); float dd_ = 0.f; \
            P10_D2(dd_, 0); P10_D2(dd_, 1); P10_D2(dd_, 2); P10_D2(dd_, 3); P10_D2(dd_, 4); P10_D2(dd_, 5); P10_D2(dd_, 6); P10_D2(dd_, 7); \
            P10_D2(dd_, 8); P10_D2(dd_, 9); P10_D2(dd_, 10); P10_D2(dd_, 11); P10_D2(dd_, 12); P10_D2(dd_, 13); P10_D2(dd_, 14); P10_D2(dd_, 15); \
            asm volatile("" : "+v"(dd_)); d_[j_] = dd_; __builtin_amdgcn_sched_barrier(0); } \
        _Pragma("unroll") for (int j_ = 0; j_ < 8; ++j_) d_[j_] = row16_sum(d_[j_]); \
        if (g == 0) { *(LAS f32x4*)(zb + s * 128 + (I0)) = (f32x4){d_[0], d_[1], d_[2], d_[3]}; *(LAS f32x4*)(zb + s * 128 + (I0) + 4) = (f32x4){d_[4], d_[5], d_[6], d_[7]}; } \
        __builtin_amdgcn_sched_barrier(0); } while (0)
        v4u raA[8], rbA[8]; v2u raB[8], rbB[8];
        P10S_LOAD8(raA, raB, UQx, 0);
#pragma unroll 1
        for (int i0 = 0; i0 < 112; i0 += 16) { P10S_LOAD8(rbA, rbB, UQx, i0 + 8); P10S_DOT8(raA, raB, i0); P10S_LOAD8(raA, raB, UQx, i0 + 16); P10S_DOT8(rbA, rbB, i0 + 8); }
        P10S_LOAD8(rbA, rbB, UQx, 120); P10S_DOT8(raA, raB, 112); P10S_DOT8(rbA, rbB, 120);
#undef P10S_DOT8
#undef P10_D2
        LDS_WAIT();
        { GAS f32x4* pd = (GAS f32x4*)(PD + (size_t)t0 * P_SEL); pd[lane] = ((const LAS f32x4*)zb)[lane]; pd[64 + lane] = ((const LAS f32x4*)zb)[64 + lane]; }
        LDS_WAIT();
    }
}
__device__ __forceinline__ void p10b_axpy(Frame& F, const float* ln1_g, const float* ln1_b) {
    int tid_ = (int)threadIdx.x; asm volatile("" : "+v"(tid_));
    const int lane = tid_ & 63, s = lane >> 4, g = lane & 15, lp = g >> 1, k = g & 1;
    const int x = (int)blockIdx.x & 7, wgi = ((int)blockIdx.x >> 3) * NWAVES + F.wave, NWX = ((F.G - x + 7) >> 3) * NWAVES;
    LAS int* idb = (LAS int*)(F.lds + RING_OFF + F.wave * 4096); LAS float* wb = (LAS float*)(idb + 512);
    const int* SELI = (const int*)(F.ws + WS_SELI); const float* SELG = (const float*)(F.ws + WS_SELG); const float* PD = (const float*)(F.ws + WS_PD); float* ST = (float*)(F.ws + WS_ST);
    const float* US = (const float*)(F.ws + WS_US); const float* VS = (const float*)(F.ws + WS_VS);
    const GAS unsigned char* VQx = (const GAS unsigned char*)(F.ws + WS_VQ + (size_t)x * P_EXP * P_SLICEB + 16 * g);
#pragma unroll 1
    for (int t4 = wgi; t4 < T_TOK / 4; t4 += NWX) {
        const int t0 = 4 * t4;
#pragma unroll
        for (int hf = 0; hf < 2; ++hf) {
            const size_t eo = (size_t)t0 * P_SEL + 256 * hf + 4 * lane;
            const v4u id = *(const GAS v4u*)(SELI + eo); const f32x4 gt = *(const GAS f32x4*)(SELG + eo);
            f32x4 z = *(const GAS f32x4*)(PD + eo);
#pragma unroll
            for (int xx = 1; xx < 8; ++xx) z += *(const GAS f32x4*)(PD + (size_t)xx * T_TOK * P_SEL + eo);
            const f32x4 us = (f32x4){US[id.x], US[id.y], US[id.z], US[id.w]}, vs = (f32x4){VS[id.x], VS[id.y], VS[id.z], VS[id.w]};
            const pg8::f32x2 g0 = pg8::gelu_pk((pg8::f32x2){z.x * us.x, z.y * us.y}), g1 = pg8::gelu_pk((pg8::f32x2){z.z * us.z, z.w * us.w});
            ((LAS v4u*)idb)[64 * hf + lane] = id;
            ((LAS f32x4*)wb)[64 * hf + lane] = (f32x4){gt.x * g0.x * vs.x, gt.y * g0.y * vs.y, gt.z * g1.x * vs.z, gt.w * g1.y * vs.w};
        }
        LDS_WAIT();
        f32x4 acc[8];
#pragma unroll
        for (int j = 0; j < 8; ++j) acc[j] = (f32x4){0.f, 0.f, 0.f, 0.f};
#define P10S_AXPY8(RA, RB, I0) do { const f32x4 wa_ = *(const LAS f32x4*)(wb + s * 128 + (I0)), wb_ = *(const LAS f32x4*)(wb + s * 128 + (I0) + 4); \
        const float we_[8] = {wa_.x, wa_.y, wa_.z, wa_.w, wb_.x, wb_.y, wb_.z, wb_.w}; \
        _Pragma("unroll") for (int j_ = 0; j_ < 8; ++j_) { asm volatile("" : "+v"(RA[j_]), "+v"(RB[j_])); \
            const v32f_t r_ = __builtin_amdgcn_cvt_scalef32_pk32_f32_fp6((v6i_t){(int)RA[j_].x, (int)RA[j_].y, (int)RA[j_].z, (int)RA[j_].w, (int)RB[j_].x, (int)RB[j_].y}, 1.0f); const float w_ = we_[j_]; \
            _Pragma("unroll") for (int q_ = 0; q_ < 8; ++q_) { acc[q_].x = fmaf(w_, r_[4 * q_], acc[q_].x); acc[q_].y = fmaf(w_, r_[4 * q_ + 1], acc[q_].y); acc[q_].z = fmaf(w_, r_[4 * q_ + 2], acc[q_].z); acc[q_].w = fmaf(w_, r_[4 * q_ + 3], acc[q_].w); } \
            asm volatile("" : "+v"(acc[0]), "+v"(acc[1]), "+v"(acc[2]), "+v"(acc[3]), "+v"(acc[4]), "+v"(acc[5]), "+v"(acc[6]), "+v"(acc[7])); __builtin_amdgcn_sched_barrier(0); } } while (0)
        v4u raA[8], rbA[8]; v2u raB[8], rbB[8];
        P10S_LOAD8(raA, raB, VQx, 0);
#pragma unroll 1
        for (int i0 = 0; i0 < 112; i0 += 16) { P10S_LOAD8(rbA, rbB, VQx, i0 + 8); P10S_AXPY8(raA, raB, i0); P10S_LOAD8(raA, raB, VQx, i0 + 16); P10S_AXPY8(rbA, rbB, i0 + 8); }
        P10S_LOAD8(rbA, rbB, VQx, 120); P10S_AXPY8(raA, raB, 112); P10S_AXPY8(rbA, rbB, 120);
#undef P10S_AXPY8
        { GAS f32x4* hp = (GAS f32x4*)(F.out + (size_t)(t0 + s) * DM + 32 * x + 4 * lp) + 64 * 8 * k; float sm = 0.f;
          const f32x4* g1 = (const f32x4*)ln1_g + 64 * 8 * k + 8 * x + lp; const f32x4* b1 = (const f32x4*)ln1_b + 64 * 8 * k + 8 * x + lp;
          asm volatile("" : "+v"(g1), "+v"(b1));
          const float m1 = ((const float*)(F.ws + WS_LNM))[t0 + s], r1 = ((const float*)(F.ws + WS_LNR))[t0 + s];
#pragma unroll
          for (int jj = 0; jj < 8; ++jj) { acc[jj] = ((hp[64 * jj] - m1) * r1 * g1[64 * jj] + b1[64 * jj]) * DN_ALPHA + acc[jj]; sm += (acc[jj].x + acc[jj].y) + (acc[jj].z + acc[jj].w); }
          sm = row16_sum(sm); const float mu = sm * (1.f / 512.f); float m2 = 0.f;
#pragma unroll
          for (int jj = 0; jj < 8; ++jj) { hp[64 * jj] = acc[jj]; const f32x4 dv = acc[jj] - mu; m2 += (dv.x * dv.x + dv.y * dv.y) + (dv.z * dv.z + dv.w * dv.w); }
          m2 = row16_sum(m2);
          if (g == 0) { GAS f32x2_t* st = (GAS f32x2_t*)(ST + ((size_t)x * T_TOK + t0 + s) * 2); *st = (f32x2_t){sm, m2}; } }
        LDS_WAIT();
    }
}
#undef P10S_LOAD8
__device__ __forceinline__ void p10c_ln2(Frame& F, const float* ln2_g, const float* ln2_b) {
    const int gw = F.vcu * NWAVES + F.wave, NGW = F.G * NWAVES, lane = ((int)threadIdx.x & 63);
    const float* ST = (const float*)(F.ws + WS_ST);
    for (int row = gw; row < T_TOK; row += NGW) {
        GAS f32x4* yr = (GAS f32x4*)(F.out + (size_t)row * DM) + lane;
        f32x4 v[16];
#pragma unroll
        for (int j = 0; j < 16; ++j) v[j] = NTLOAD(yr + 64 * j);
        const f32x2_t st = *(const GAS f32x2_t*)(ST + ((size_t)(lane & 7) * T_TOK + row) * 2);
        float sm = st.x; sm += __shfl_xor(sm, 1); sm += __shfl_xor(sm, 2); sm += __shfl_xor(sm, 4);
        const float mean = sm * (1.f / DM);
        const float dm = st.x * (1.f / 512.f) - mean; float m2 = st.y + 512.f * dm * dm; m2 += __shfl_xor(m2, 1); m2 += __shfl_xor(m2, 2); m2 += __shfl_xor(m2, 4);
        const float rstd = 1.f / sqrtf(m2 * (1.f / DM) + LN_EPS);
#pragma unroll
        for (int j = 0; j < 16; ++j) { const f32x4 g = ((const f32x4*)ln2_g)[64 * j + lane], b = ((const f32x4*)ln2_b)[64 * j + lane];
            __builtin_nontemporal_store((v[j] - mean) * rstd * g + b, yr + 64 * j); }
    }
}
struct DaGetVS {
    unsigned char* ws; int g, G;
    __device__ __forceinline__ att::BlockRefVS operator()(int i) const {
        const bf16_t* Qb = (const bf16_t*)(ws + WS_QKV) + 3 * QKV_T; const bf16_t* Kb = Qb + QKV_T; const bf16_t* Vb = Kb + QKV_T; bf16_t* O1 = (bf16_t*)(ws + WS_O1); bf16_t* O2 = (bf16_t*)(ws + WS_O2);
        const int L = g + (i >> 1) * G, second = i & 1;
        const int xcd = L & 7, j = (L >> 3) & 31, rr = L >> 8;
        const int y = j & 15, qk = j >> 4, bh = rr * 8 + xcd, b = bh >> 3, h = bh & 7;
        const int qb = second ? 31 - y : y, hq = 2 * h + qk;
        att::BlockRefVS r;
        r.Q = Qb + ((size_t)(b * 16 + hq) * SEQ + (size_t)qb * 128) * 128; r.K = Kb + (size_t)(b * 16 + hq) * SEQ * 128; r.Vlo = Vb + (size_t)(b * 16 + 2 * h) * SEQ * 128;
        r.O = (qk ? O2 : O1) + ((size_t)b * SEQ + (size_t)qb * 128) * 2048 + h * 256; r.P0 = qb * 128;
        return r;
    }
};
struct SbGet {
    unsigned char* ws; int g, G;
    __device__ __forceinline__ att::BlockRef operator()(int i) const {
        const bf16_t* Qb = (const bf16_t*)(ws + WS_QKV); const bf16_t* Kb = Qb + QKV_T; const bf16_t* Vb = Kb + QKV_T; bf16_t* O = (bf16_t*)(ws + WS_OSB);
        const int L = g + i * G, bh = L >> 4, qb = L & 15, b = bh >> 4, h = bh & 15;
        att::BlockRef r;
        r.Q = Qb + ((size_t)bh * SEQ + (size_t)qb * 256) * 128; r.K = Kb + (size_t)bh * SEQ * 128; r.V = Vb + (size_t)bh * SEQ * 128;
        r.O = O + ((size_t)b * SEQ + (size_t)qb * 256) * 2048 + h * 128; r.P0 = qb * 256;
        return r;
    }
};

struct Args;
#define KARGS() ({ const __attribute__((address_space(4))) Args* p_ = (const __attribute__((address_space(4))) Args*)__builtin_amdgcn_kernarg_segment_ptr(); asm volatile("" : "+s"(p_)); p_; })
struct Args { const void* in[20]; float* out; unsigned char* ws; int ph_lo, ph_hi, li, pad; };
__global__ void __launch_bounds__(NWAVES * 64, 2) fwd(Args args) {
    extern __shared__ __attribute__((aligned(16))) unsigned char lds[];
    Frame F;
    F.lds = (LAS unsigned char*)lds;
    F.wave = __builtin_amdgcn_readfirstlane((int)threadIdx.x >> 6);
    F.G = gridDim.x; { const int bx = blockIdx.x; F.vcu = (F.G % 8 == 0) ? (bx % 8) * (F.G / 8) + bx / 8 : bx; }
    F.out = args.out; F.ws = args.ws;
    unsigned char* ws = args.ws;
    gu32* ctl = (gu32*)(ws + WS_CTL);
    for (int u = (int)threadIdx.x; u < (LDS_BYTES - LDSCTL_OFF) / 4; u += NWAVES * 64) ((LAS unsigned*)(F.lds + LDSCTL_OFF))[u] = 0u;
    __syncthreads();
    XcdBarrier bar; bar.bar = (unsigned*)(ctl + CW_BAR); bar.x = 0; bar.st = nullptr;
    if (N_LAUNCHES == 1) bar = xcd_barrier_post((unsigned*)(ctl + CW_BAR), (volatile LAS unsigned*)(F.lds + MISC_OFF) + 8);
#define GRID_BAR() do { if (N_LAUNCHES == 1) xcd_barrier(bar); } while (0)
    const int lo = args.ph_lo, hi = args.ph_hi;
#define IN(k) (lo <= (k) && (k) < hi)
#define BOTH(k) (IN(k) && IN((k) + 1))
    bf16_t* XB = (bf16_t*)(ws + WS_XB); bf16_t* WINT = (bf16_t*)(ws + WS_WIN); bf16_t* GATE = (bf16_t*)(ws + WS_GATE); bf16_t* QKV = (bf16_t*)(ws + WS_QKV);
    bf16_t* OSB = (bf16_t*)(ws + WS_OSB); bf16_t* O1 = (bf16_t*)(ws + WS_O1); bf16_t* O2 = (bf16_t*)(ws + WS_O2);

    if (IN(0)) { const auto* ka = KARGS(); p0_prologue(F, (const float*)ka->in[0], (const int*)ka->in[1], (const float*)ka->in[2], (const float*)ka->in[9], (const float*)ka->in[10], (const float*)ka->in[11], (const float*)ka->in[14], (const float*)ka->in[15]); GRID_BAR(); p0b_weights(F, (const float*)ka->in[2], (const float*)ka->in[9], (const float*)ka->in[10], (const float*)ka->in[11]); if (BOTH(0)) GRID_BAR(); }
    if (IN(1)) {
        pg8::Gemm g{XB, WINT, T_TOK, IN_W, DM / 2}; pg8::StaticOrder S; S.init(T_TOK, IN_W, F.G, (int)blockIdx.x);
        const auto* ka = KARGS(); pg8::EpiProj E{QKV, GATE, (const float*)ka->in[3], (const float*)(ws + WS_ROPEC), (const float*)(ws + WS_ROPES), (const float*)(ws + WS_SX), (const float*)(ws + WS_SW)};
        pg8::gemm_phase<pg8::EpiProj, pg8::StaticOrder, true, true, true>(F.lds + RING_OFF, g, S, E);
        if (BOTH(1)) GRID_BAR();
    }
    if (IN(2)) {
        const int g = (int)blockIdx.x, G = F.G;
        { const DaGetVS get{ws, g, G};
          const int nit = g < 1024 ? (1024 - g + G - 1) / G : 0;
          att::attn_stream_vs<SEQ>(2 * nit, get, (char*)lds + RING_OFF);
          }
        { const SbGet get{ws, g, G};
          const int nb = g < 1024 ? (1024 - g + G - 1) / G : 0;
          att::attn_stream<1>(nb, get, 2048, (char*)lds + RING_OFF);
          }
        if (BOTH(2)) GRID_BAR();
    }
    if (IN(3)) { const auto* ka = KARGS(); p3_combine(F, (const float*)ka->in[4], (const float*)ka->in[5], (const float*)ka->in[6], (const float*)ka->in[7], (const float*)ka->in[8], (const float*)ka->in[16], (const float*)ka->in[17]); if (BOTH(3)) GRID_BAR(); }
    if (IN(4)) {
        pg8::Gemm g{(const bf16_t*)(ws + WS_OSBQ), (const bf16_t*)(ws + WS_WSB), T_TOK, DM, 1024}; pg8::StaticOrder S; S.init(T_TOK, DM, F.G, (int)blockIdx.x);
        pg8::EpiBranch<0> E{GATE, XB, (const float*)(ws + WS_SOSB), (const float*)(ws + WS_SW) + IN_W, nullptr};
        pg8::gemm_phase<pg8::EpiBranch<0>, pg8::StaticOrder, true, true, true>(F.lds + RING_OFF, g, S, E);
    }
    if (IN(5)) {
        pg8::Gemm g{(const bf16_t*)(ws + WS_ODAQ), (const bf16_t*)(ws + WS_WDA), T_TOK, DM, 1024}; pg8::StaticOrder S; S.init(T_TOK, DM, F.G, (int)blockIdx.x);
        pg8::EpiBranch<1> E{GATE, XB, (const float*)(ws + WS_SODA), (const float*)(ws + WS_SW) + IN_W + DM, (unsigned*)(ws + WS_RM)};
        pg8::gemm_phase<pg8::EpiBranch<1>, pg8::StaticOrder, true, true, true>(F.lds + RING_OFF, g, S, E);
        GRID_BAR(); p5b_quant(F);
        if (BOTH(5)) GRID_BAR();
    }
    if (IN(6)) {
        pg8::Gemm g{(const bf16_t*)(ws + WS_MQ), (const bf16_t*)(ws + WS_WOUT), T_TOK, DM, DM / 2}; pg8::StaticOrder S; S.init(T_TOK, DM, F.G, (int)blockIdx.x);
        const auto* ka = KARGS(); pg8::EpiResid E{(const float*)ka->in[0], F.out, (const float*)(ws + WS_SM), (const float*)(ws + WS_SW) + IN_W + 2 * DM};
        pg8::gemm_phase<pg8::EpiResid, pg8::StaticOrder, true, true, true>(F.lds + RING_OFF, g, S, E);
        if (BOTH(6)) GRID_BAR();
    }
    if (IN(7)) { const auto* ka = KARGS(); p7_ln1(F, (const float*)ka->in[12], (const float*)ka->in[13]); if (BOTH(7)) GRID_BAR(); }
    if (IN(8)) {
        pg8::Gemm g{(const bf16_t*)(ws + WS_H1Q), (const bf16_t*)(ws + WS_WPQ), T_TOK, 2048, DM / 2}; pg8::StaticOrder S; S.init(T_TOK, 2048, F.G, (int)blockIdx.x);
        pg8::EpiF32 E{(float*)(ws + WS_XB), 2048, (const float*)(ws + WS_HS), (const float*)(ws + WS_SWP)};
        pg8::gemm_phase<pg8::EpiF32, pg8::StaticOrder, true, true, true>(F.lds + RING_OFF, g, S, E);
        if (BOTH(8)) GRID_BAR();
    }
    if (IN(9)) { p9_topk(F); if (BOTH(9)) GRID_BAR(); }
    if (IN(10)) { { const auto* ka = KARGS(); p10a_dots(F, (const float*)ka->in[12], (const float*)ka->in[13]); } GRID_BAR();
                  { const auto* ka = KARGS(); p10b_axpy(F, (const float*)ka->in[12], (const float*)ka->in[13]); } GRID_BAR();
                  { const auto* ka = KARGS(); p10c_ln2(F, (const float*)ka->in[18], (const float*)ka->in[19]); } }
#undef IN
#undef BOTH
#undef GRID_BAR
}

extern "C" void kernel_launch(void* const* d_in, const int* in_sizes, int n_in, void* d_out, int out_size, void* d_ws, size_t ws_size, hipStream_t stream) {
    static int grid = 0;
    if (grid == 0) {
        if (n_in != 20 || out_size != T_TOK * DM || ws_size < WS_END) { fprintf(stderr, "kernel_launch: built for 20 inputs, out of %d floats, >= %zu bytes of workspace; got n_in %d, out %d, ws %zu; nothing launched\n", T_TOK * DM, (size_t)WS_END, n_in, out_size, ws_size); grid = -1; return; }
        int dev = 0, cus = 0, per_cu = 0;
        if (hipGetDevice(&dev) != hipSuccess || hipDeviceGetAttribute(&cus, hipDeviceAttributeMultiprocessorCount, dev) != hipSuccess) { fprintf(stderr, "kernel_launch: device query failed\n"); grid = -1; return; }
        if (hipFuncSetAttribute((const void*)fwd, hipFuncAttributeMaxDynamicSharedMemorySize, LDS_BYTES) != hipSuccess) { fprintf(stderr, "kernel_launch: hipFuncSetAttribute failed\n"); grid = -1; return; }
        if (hipOccupancyMaxActiveBlocksPerMultiprocessor(&per_cu, (const void*)fwd, NWAVES * 64, LDS_BYTES) != hipSuccess || per_cu < 1)
            fprintf(stderr, "kernel_launch: note: occupancy query reports %d workgroups per CU\n", per_cu);
        (void)hipGetLastError();
        grid = cus;
    }
    if (grid < 0) return;
    if (hipMemsetAsync((char*)d_ws + WS_CTL, 0, CTL_ZERO_BYTES, stream) != hipSuccess) { fprintf(stderr, "kernel_launch: hipMemsetAsync failed\n"); return; }
    Args a{};
    for (int i = 0; i < 20; ++i) a.in[i] = d_in[i];
    a.out = (float*)d_out; a.ws = (unsigned char*)d_ws;
    for (int li = 0; li < N_LAUNCHES; ++li) {
        a.ph_lo = (N_LAUNCHES == 1) ? 0 : li; a.ph_hi = (N_LAUNCHES == 1) ? N_PHASES : li + 1; a.li = li; a.pad = 0;
        hipLaunchKernelGGL(fwd, dim3(grid), dim3(NWAVES * 64), LDS_BYTES, stream, a);
        const hipError_t le = hipPeekAtLastError();
        if (le != hipSuccess) { fprintf(stderr, "kernel_launch: launch %d failed: %s\n", li, hipGetErrorName(le)); break; }
    }
}
```
